# Optimizing an MI355X kernel written in HIP

```python
import jax
import jax.numpy as jnp
from jax import lax
import numpy as np

D_MODEL = 1024
BATCH = 32
SEQ = 256
DEPTH = 1
DEC_BATCH = 2
DEC_SEQ = 1024
PAST_LEN = 512

GRID_W = 64
HEAD_DIM = 64
N_Q_HEADS = 8
N_KV_HEADS = 2
Q_GROUP = N_Q_HEADS // N_KV_HEADS
ATTN_Q_W = N_Q_HEADS * HEAD_DIM
ATTN_KV_W = N_KV_HEADS * HEAD_DIM
Q_BLOCK = 128
ROPE_THETA = 10000.0
DN_HEADS = 8
DN_DK = 64
DN_DV = 64
DN_QK_W = DN_HEADS * DN_DK
DN_V_W = DN_HEADS * DN_DV
DN_CONV = 5
DN_CHUNK = 64
D_FF = -(-8 * D_MODEL // (3 * 256)) * 256
EPS = 1e-6
IN_WIDTHS = (ATTN_Q_W, ATTN_KV_W, ATTN_KV_W, DN_QK_W, DN_QK_W, DN_V_W, DN_V_W,
             2 * DN_HEADS, 2 * DN_HEADS, D_MODEL, D_MODEL)
IN_W = sum(IN_WIDTHS)

kernel_name = 'hybrid_gqa_gdn_prefix_diffusion_step'


def rms_norm(x, g):
    xf = x.astype(jnp.float32)
    y = xf * lax.rsqrt(jnp.mean(xf * xf, axis=-1, keepdims=True) + EPS)
    return (y * g.astype(jnp.float32)).astype(x.dtype)


def l2_norm(x):
    xf = x.astype(jnp.float32)
    return xf * lax.rsqrt(jnp.sum(xf * xf, axis=-1, keepdims=True) + EPS)


def rope_1d(x, pos):
    half = x.shape[-1] // 2
    inv = ROPE_THETA ** (-jnp.arange(half, dtype=jnp.float32) / half)
    ang = pos[:, None] * inv[None, :]
    cos = jnp.cos(ang)[None, :, None, :]
    sin = jnp.sin(ang)[None, :, None, :]
    x1, x2 = x[..., :half], x[..., half:]
    return jnp.concatenate([x1 * cos - x2 * sin, x2 * cos + x1 * sin], axis=-1)


def axial_rope(x):
    n_tokens = x.shape[1]
    rows = n_tokens // GRID_W
    row_pos = jnp.repeat(jnp.arange(rows, dtype=jnp.float32), GRID_W)
    col_pos = jnp.tile(jnp.arange(GRID_W, dtype=jnp.float32), rows)
    xf = x.astype(jnp.float32)
    ax = HEAD_DIM // 2
    out = jnp.concatenate([rope_1d(xf[..., :ax], row_pos), rope_1d(xf[..., ax:], col_pos)], axis=-1)
    return out.astype(x.dtype)


def block_attention(q, k, v):
    b, sq = q.shape[0], q.shape[1]
    nb = sq // Q_BLOCK
    qb = q.reshape(b, nb, Q_BLOCK, N_KV_HEADS, Q_GROUP, HEAD_DIM).transpose(1, 0, 2, 3, 4, 5)
    scale = HEAD_DIM ** -0.5

    def one_block(q_blk):
        s = jnp.einsum('bqhgd,bkhd->bhgqk', q_blk, k, preferred_element_type=jnp.float32) * scale
        p = jax.nn.softmax(s, axis=-1)
        return jnp.einsum('bhgqk,bkhd->bqhgd', p.astype(v.dtype), v)

    o = lax.map(one_block, qb)
    return o.transpose(1, 0, 2, 3, 4, 5).reshape(b, sq, ATTN_Q_W)


def short_conv(x, w):
    ch = x.shape[-1]
    pad = (DN_CONV - 1) // 2
    y = lax.conv_general_dilated(x, w[:, None, :].astype(x.dtype), window_strides=(1,),
                                 padding=[(pad, pad)], dimension_numbers=('NWC', 'WIO', 'NWC'),
                                 feature_group_count=ch)
    return jax.nn.silu(y)


def chunk_gated_delta(q, k, v, g, beta, s0):
    b, s, h, dk = q.shape
    dv = v.shape[-1]
    n = s // DN_CHUNK
    c = DN_CHUNK

    def chunks(a):
        return a.reshape(b, n, c, *a.shape[2:]).swapaxes(2, 3)

    q = chunks(q) * (dk ** -0.5)
    k = chunks(k)
    v = chunks(v)
    g = jnp.cumsum(chunks(g), axis=-1)
    beta = chunks(beta)
    k_beta = k * beta[..., None]
    v_beta = v * beta[..., None]
    tril_incl = jnp.tril(jnp.ones((c, c), dtype=bool))
    tril_strict = jnp.tril(jnp.ones((c, c), dtype=bool), -1)
    decay = jnp.exp(jnp.where(tril_incl, g[..., :, None] - g[..., None, :], -jnp.inf))
    lmat = jnp.where(tril_strict, jnp.einsum('bnhid,bnhjd->bnhij', k_beta, k) * decay, 0.0)
    eye = jnp.eye(c, dtype=jnp.float32)
    t_inv = lax.linalg.triangular_solve(eye + lmat, jnp.broadcast_to(eye, lmat.shape),
                                        left_side=True, lower=True, unit_diagonal=True)
    u = jnp.einsum('bnhij,bnhjd->bnhid', t_inv, v_beta)
    w = jnp.einsum('bnhij,bnhjd->bnhid', t_inv, k_beta * jnp.exp(g)[..., None])
    a_intra = jnp.where(tril_incl, jnp.einsum('bnhid,bnhjd->bnhij', q, k) * decay, 0.0)

    def step(state, xs):
        q_i, k_i, u_i, w_i, g_i, a_i = xs
        v_new = u_i - jnp.einsum('bhcd,bhde->bhce', w_i, state)
        o_i = (jnp.einsum('bhcd,bhde->bhce', q_i * jnp.exp(g_i)[..., None], state)
               + jnp.einsum('bhij,bhje->bhie', a_i, v_new))
        g_last = g_i[..., -1]
        state = (state * jnp.exp(g_last)[..., None, None]
                 + jnp.einsum('bhcd,bhce->bhde', k_i * jnp.exp(g_last[..., None] - g_i)[..., None], v_new))
        return state, o_i

    xs = tuple(a.swapaxes(0, 1) for a in (q, k, u, w, g, a_intra))
    s_final, o = lax.scan(step, s0.astype(jnp.float32), xs)
    o = o.transpose(1, 0, 3, 2, 4).reshape(b, s, h, dv)
    return o, s_final


def delta_branch(dq, dk_, dv_, dz, dbeta, dalpha, conv_w, a_log, dt_bias, dn_norm_g, s_f, s_b):
    b, s = dq.shape[0], dq.shape[1]
    qkv = short_conv(jnp.concatenate([dq, dk_, dv_], axis=-1), conv_w)
    cq, ck, cv = jnp.split(qkv, [DN_QK_W, 2 * DN_QK_W], axis=-1)
    cq = l2_norm(cq.reshape(b, s, DN_HEADS, DN_DK))
    ck = l2_norm(ck.reshape(b, s, DN_HEADS, DN_DK))
    cv = cv.reshape(b, s, DN_HEADS, DN_DV).astype(jnp.float32)
    beta = jax.nn.sigmoid(dbeta.astype(jnp.float32)).reshape(b, s, 2, DN_HEADS)
    g = -jnp.exp(a_log.astype(jnp.float32)) * jax.nn.softplus(
        dalpha.astype(jnp.float32).reshape(b, s, 2, DN_HEADS) + dt_bias.astype(jnp.float32))
    o_f, sf = chunk_gated_delta(cq, ck, cv, g[:, :, 0], beta[:, :, 0], s_f)
    flip = lambda a: a[:, ::-1]
    o_b, sb = chunk_gated_delta(flip(cq), flip(ck), flip(cv), flip(g[:, :, 1]), flip(beta[:, :, 1]), s_b)
    o = rms_norm(o_f + flip(o_b), dn_norm_g) * jax.nn.silu(dz.astype(jnp.float32).reshape(b, s, DN_HEADS, DN_DV))
    return o.reshape(b, s, DN_V_W).astype(dq.dtype), sf, sb


def mixer_block(h, lw, ctx):
    b, s = h.shape[0], h.shape[1]
    split_idx = np.cumsum(IN_WIDTHS)[:-1].tolist()
    aq, ak, av, dq, dk_, dv_, dz, dbeta, dalpha, ga, gb = jnp.split(h @ lw['w_in'], split_idx, axis=-1)
    q = rms_norm(aq.reshape(b, s, N_Q_HEADS, HEAD_DIM), lw['q_norm_g'])
    k = rms_norm(ak.reshape(b, s, N_KV_HEADS, HEAD_DIM), lw['k_norm_g'])
    v = av.reshape(b, s, N_KV_HEADS, HEAD_DIM)
    if ctx is None:
        o_a = block_attention(q, k, v)
        zero = jnp.zeros((b, DN_HEADS, DN_DK, DN_DV), jnp.float32)
        s_f0, s_b0 = zero, zero
    else:
        ctx_k, ctx_v, s_f0, s_b0 = ctx
        keys = jnp.concatenate([ctx_k.astype(k.dtype), axial_rope(k)], axis=1)
        vals = jnp.concatenate([ctx_v.astype(v.dtype), v], axis=1)
        o_a = block_attention(axial_rope(q), keys, vals)
    o_d, sf, sb = delta_branch(dq, dk_, dv_, dz, dbeta, dalpha, lw['conv_w'], lw['a_log'], lw['dt_bias'],
                               lw['dn_norm_g'], s_f0, s_b0)
    merged = jax.nn.sigmoid(ga) * (o_a @ lw['w_pa']) + jax.nn.sigmoid(gb) * (o_d @ lw['w_pb'])
    return merged @ lw['w_o'], (k, v, sf, sb)


def layer_forward(x, mod, lw, ctx):
    sh1, sc1, g1, sh2, sc2, g2 = jnp.split(mod.astype(x.dtype), 6, axis=-1)
    h = rms_norm(x, lw['norm1_g']) * (1.0 + sc1) + sh1
    mix, ctx_out = mixer_block(h, lw, ctx)
    x = x + g1 * mix
    h2 = rms_norm(x, lw['norm2_g']) * (1.0 + sc2) + sh2
    ffn = (jax.nn.silu(h2 @ lw['w_gate']) * (h2 @ lw['w_up'])) @ lw['w_down']
    return x + g2 * ffn, ctx_out


def setup_inputs(seed: int = 0) -> dict:
    key = jax.random.key(seed)
    ks = jax.random.split(key, 32)
    nrm = lambda k, shape, s: jax.random.normal(k, shape, jnp.float32) * s
    dt = jax.random.uniform(ks[13], (DEPTH, 2, DN_HEADS), jnp.float32, 0.001, 0.1)
    return {
        'x_prompt': nrm(ks[0], (BATCH, SEQ, D_MODEL), 1.0),
        'x_sample': nrm(ks[1], (DEC_BATCH, DEC_SEQ, D_MODEL), 1.0),
        'cache_k': nrm(ks[2], (DEC_BATCH, DEPTH, PAST_LEN, N_KV_HEADS, HEAD_DIM), 1.0),
        'cache_v': nrm(ks[3], (DEC_BATCH, DEPTH, PAST_LEN, N_KV_HEADS, HEAD_DIM), 1.0),
        'state_fwd': nrm(ks[4], (DEC_BATCH, DEPTH, DN_HEADS, DN_DK, DN_DV), 0.1),
        'state_bwd': nrm(ks[5], (DEC_BATCH, DEPTH, DN_HEADS, DN_DK, DN_DV), 0.1),
        'c': nrm(ks[6], (DEC_BATCH, D_MODEL), 1.0),
        'c_ctx': nrm(ks[7], (D_MODEL,), 1.0),
        'w_ada': nrm(ks[8], (DEPTH, D_MODEL, 6 * D_MODEL), 0.5 * D_MODEL ** -0.5),
        'b_ada': nrm(ks[9], (DEPTH, 6 * D_MODEL), 0.02),
        'norm1_g': 1.0 + nrm(ks[10], (DEPTH, D_MODEL), 0.1),
        'w_in': nrm(ks[11], (DEPTH, D_MODEL, IN_W), D_MODEL ** -0.5),
        'q_norm_g': 1.0 + nrm(ks[12], (DEPTH, HEAD_DIM), 0.1),
        'k_norm_g': 1.0 + nrm(ks[14], (DEPTH, HEAD_DIM), 0.1),
        'conv_w': nrm(ks[15], (DEPTH, DN_CONV, 2 * DN_QK_W + DN_V_W), DN_CONV ** -0.5),
        'a_log': jnp.log(jax.random.uniform(ks[16], (DEPTH, 2, DN_HEADS), jnp.float32, 1.0, 16.0)),
        'dt_bias': jnp.log(jnp.expm1(dt)),
        'dn_norm_g': 1.0 + nrm(ks[17], (DEPTH, DN_DV), 0.1),
        'w_pa': nrm(ks[18], (DEPTH, ATTN_Q_W, D_MODEL), ATTN_Q_W ** -0.5),
        'w_pb': nrm(ks[19], (DEPTH, DN_V_W, D_MODEL), DN_V_W ** -0.5),
        'w_o': nrm(ks[20], (DEPTH, D_MODEL, D_MODEL), D_MODEL ** -0.5),
        'norm2_g': 1.0 + nrm(ks[21], (DEPTH, D_MODEL), 0.1),
        'w_gate': nrm(ks[22], (DEPTH, D_MODEL, D_FF), D_MODEL ** -0.5),
        'w_up': nrm(ks[23], (DEPTH, D_MODEL, D_FF), D_MODEL ** -0.5),
        'w_down': nrm(ks[24], (DEPTH, D_FF, D_MODEL), D_FF ** -0.5),
    }


def reference(x_prompt, x_sample, cache_k, cache_v, state_fwd, state_bwd, c, c_ctx,
              w_ada, b_ada, norm1_g, w_in, q_norm_g, k_norm_g, conv_w, a_log, dt_bias, dn_norm_g,
              w_pa, w_pb, w_o, norm2_g, w_gate, w_up, w_down):
    y_prompt = x_prompt
    y_sample = x_sample
    ks_out, vs_out, sf_out, sb_out = [], [], [], []
    for l in range(DEPTH):
        lw = dict(w_in=w_in[l], q_norm_g=q_norm_g[l], k_norm_g=k_norm_g[l], conv_w=conv_w[l],
                  a_log=a_log[l], dt_bias=dt_bias[l], dn_norm_g=dn_norm_g[l], w_pa=w_pa[l], w_pb=w_pb[l],
                  w_o=w_o[l], norm1_g=norm1_g[l], norm2_g=norm2_g[l], w_gate=w_gate[l], w_up=w_up[l],
                  w_down=w_down[l])
        mod_ctx = (jax.nn.silu(c_ctx) @ w_ada[l] + b_ada[l]).reshape(1, 1, 6 * D_MODEL)
        y_prompt, (k_c, v_c, sf_c, sb_c) = layer_forward(y_prompt, mod_ctx, lw, None)
        ks_out.append(k_c)
        vs_out.append(v_c)
        sf_out.append(sf_c)
        sb_out.append(sb_c)
        mod_lat = (jax.nn.silu(c) @ w_ada[l] + b_ada[l])[:, None, :]
        ctx = (cache_k[:, l], cache_v[:, l], state_fwd[:, l], state_bwd[:, l])
        y_sample, _ = layer_forward(y_sample, mod_lat, lw, ctx)
    new_cache_k = jnp.stack(ks_out, axis=1)
    new_cache_v = jnp.stack(vs_out, axis=1)
    new_state_fwd = jnp.stack(sf_out, axis=1)
    new_state_bwd = jnp.stack(sb_out, axis=1)
    return (y_prompt, y_sample, new_cache_k, new_cache_v, new_state_fwd, new_state_bwd)
```

```cpp
#ifndef HOST_EMU
#include <hip/hip_runtime.h>
#include <hip/hip_cooperative_groups.h>
namespace cg = cooperative_groups;
#define DEVFN __device__ __forceinline__
#else
#include <cmath>
#include <cstring>
#include <cstdint>
#include <cstddef>
#define DEVFN static inline
#endif
#include <cstdio>

#ifdef SMALL_DIMS
constexpr int BATCH = 3, SEQ = 128, DEC_BATCH = 2, DEC_SEQ = 256, PAST = 128;
#else
constexpr int BATCH = 32, SEQ = 256, DEC_BATCH = 2, DEC_SEQ = 1024, PAST = 512;
#endif
constexpr int D = 1024, HD = 64, NQH = 8, NKVH = 2, DNH = 8, FF = 2816, GRID_W = 64;
constexpr int TP = BATCH * SEQ, TL = DEC_BATCH * DEC_SEQ, T = TP + TL, NMOD = 1 + DEC_BATCH, NSEQ = BATCH + DEC_BATCH;
constexpr int IN_W = 4896;
constexpr int C_AQ = 0, C_AK = 512, C_AV = 640, C_DQ = 768, C_DZ = 2304, C_GA = 2816, C_GB = 3840, C_BETA = 4864, C_ALPHA = 4880, N_MAIN = 4864;
#ifndef HOST_EMU
__host__ __device__
#endif
inline int wsrc_col(int c) { return c < 2816 ? c : (c < N_MAIN ? c + 32 : c - N_MAIN + 2816); }
constexpr float EPS = 1e-6f;
constexpr size_t O_Y = 0, O_K = (size_t)T * D, O_V = O_K + (size_t)TP * 128, O_SF = O_V + (size_t)TP * 128, O_SB = O_SF + (size_t)BATCH * 8 * 64 * 64,
                 O_END = O_SB + (size_t)BATCH * 8 * 64 * 64;

typedef unsigned short bf16_t;
DEVFN bf16_t f2bf(float f) { unsigned u; memcpy(&u, &f, 4); u = (u + 0x7fffu + ((u >> 16) & 1u)) >> 16; return (bf16_t)u; }
DEVFN float bf2f(bf16_t h) { unsigned u = ((unsigned)h) << 16; float f; memcpy(&f, &u, 4); return f; }
DEVFN float ldf(const float* p, size_t i) { return p[i]; }
DEVFN float ldf(const bf16_t* p, size_t i) { return bf2f(p[i]); }
DEVFN void stf(float* p, size_t i, float v) { p[i] = v; }
DEVFN void stf(bf16_t* p, size_t i, float v) { p[i] = f2bf(v); }
DEVFN float siluf(float x) { return x / (1.f + expf(-x)); }
DEVFN float sigmf(float x) { return 1.f / (1.f + expf(-x)); }
DEVFN float softplusf(float x) { return x > 20.f ? x : log1pf(expf(x)); }
#ifndef HOST_EMU
DEVFN float fsin(float x) { return __sinf(x); }
DEVFN float fcos(float x) { return __cosf(x); }
#else
DEVFN float fsin(float x) { return sinf(x); }
DEVFN float fcos(float x) { return cosf(x); }
#endif

typedef bf16_t proj_t;
typedef bf16_t act_t;
typedef bf16_t conv_t;
typedef bf16_t h_t;
typedef bf16_t o_t;
typedef bf16_t qk_t;
constexpr size_t al256(size_t x) { return (x + 255) & ~(size_t)255; }
constexpr size_t WS_BAR = 0;
constexpr size_t WS_MOD = 16384;
constexpr size_t WS_ZERO_BYTES = WS_MOD + (size_t)NMOD * 6 * D * 4;
constexpr size_t WS_WIN = al256(WS_MOD + (size_t)NMOD * 6 * D * 4);
constexpr size_t WS_WPA = al256(WS_WIN + (size_t)IN_W * D * 2);
constexpr size_t WS_WPB = al256(WS_WPA + (size_t)D * 512 * 2);
constexpr size_t WS_WO = al256(WS_WPB + (size_t)D * 512 * 2);
constexpr size_t WS_WGU = al256(WS_WO + (size_t)D * D * 2);
constexpr size_t WS_WDN = al256(WS_WGU + (size_t)2 * FF * D * 2);
constexpr size_t WS_H = al256(WS_WDN + (size_t)D * FF * 2);
static_assert((size_t)T * D * sizeof(h_t) == (size_t)T * 512 * 4, "odir fwd overlay");
constexpr size_t WS_QK = al256(WS_H + (size_t)T * D * sizeof(h_t));
constexpr size_t WS_OD1 = al256(WS_QK + (size_t)T * 640 * sizeof(qk_t));
constexpr size_t WS_QK_END = al256(WS_OD1 + (size_t)T * 512 * 4);
constexpr size_t WS_PROJ = WS_QK_END;
constexpr size_t WS_OA = al256(WS_PROJ + (size_t)T * IN_W * sizeof(proj_t));
constexpr size_t WS_OD = al256(WS_OA + (size_t)T * 512 * sizeof(o_t));
constexpr size_t WS_CONV = al256(WS_OD + (size_t)T * 512 * sizeof(o_t));
constexpr size_t WS_MG = WS_CONV, WS_TMP = al256(WS_MG + (size_t)T * D * sizeof(o_t));
constexpr size_t WS_X1 = WS_TMP;
constexpr size_t WS_CONV_END = al256(WS_TMP + (size_t)T * D * sizeof(o_t));
static_assert(WS_CONV_END - WS_CONV >= (size_t)T * 1536 * sizeof(conv_t), "conv region");
constexpr size_t WS_GB = WS_CONV_END;
constexpr int NCHUNK = BATCH * 16 * (SEQ / 64) + DEC_BATCH * 16 * (DEC_SEQ / 64);
constexpr size_t WS_SLW = WS_H;
constexpr size_t WS_SLU = WS_OD1;
static_assert((size_t)NCHUNK * 8192 <= (size_t)T * D * sizeof(h_t) && (size_t)NCHUNK * 8192 <= (size_t)T * 512 * 4, "slab overlays");
constexpr size_t SLA_BYTES = 10 * 512 + 512;
constexpr size_t WS_SLA = al256(WS_GB + (size_t)T * 32 * 4 + 256);
constexpr int NCHUNK_LAT = DEC_BATCH * 16 * (DEC_SEQ / 64), CHUNK_LAT0 = BATCH * 16 * (SEQ / 64);
constexpr size_t WS_SLV = al256(WS_SLA + (size_t)NCHUNK_LAT * SLA_BYTES);
constexpr size_t WS_END = al256(WS_SLV + (size_t)NCHUNK_LAT * 8192);

struct Prm {
    const float *x_prompt, *x_sample, *cache_k, *cache_v, *state_fwd, *state_bwd, *c, *c_ctx, *w_ada, *b_ada, *norm1_g, *w_in, *q_norm_g, *k_norm_g,
        *conv_w, *a_log, *dt_bias, *dn_norm_g, *w_pa, *w_pb, *w_o, *norm2_g, *w_gate, *w_up, *w_down;
    float* out; unsigned char* ws;
};
DEVFN const float* xrow(const Prm& p, int t) { return t < TP ? p.x_prompt + (size_t)t * D : p.x_sample + (size_t)(t - TP) * D; }
DEVFN int modidx(int t) { return t < TP ? 0 : 1 + (t - TP) / DEC_SEQ; }
DEVFN void seqinfo(int s, int& start, int& len) { if (s < BATCH) { start = s * SEQ; len = SEQ; } else { start = TP + (s - BATCH) * DEC_SEQ; len = DEC_SEQ; } }
DEVFN void tokinfo(int t, int& s, int& pos) { if (t < TP) { s = t / SEQ; pos = t % SEQ; } else { s = BATCH + (t - TP) / DEC_SEQ; pos = (t - TP) % DEC_SEQ; } }

DEVFN void n0_mod(const Prm& p, long gtid, long gn) {
    float* mod = (float*)(p.ws + WS_MOD);
    for (long i = gtid; i < (long)NMOD * 6 * D; i += gn) {
        const int m = (int)(i / (6 * D)), j = (int)(i % (6 * D));
        const float* cond = m == 0 ? p.c_ctx : p.c + (size_t)(m - 1) * D;
        float s = 0.f;
        for (int k = 0; k < D; ++k) s += siluf(cond[k]) * p.w_ada[(size_t)k * 6 * D + j];
        mod[i] = s + p.b_ada[j];
    }
}
DEVFN void n_norm(const Prm& p, int which, long gtid, long gn) {
    const float* mod = (const float*)(p.ws + WS_MOD);
    h_t* h = (h_t*)(p.ws + WS_H);
    for (long t = gtid; t < T; t += gn) {
        const float* x = which == 0 ? xrow(p, (int)t) : p.out + O_Y + (size_t)t * D;
        const float* g = which == 0 ? p.norm1_g : p.norm2_g;
        const float* sh = mod + (size_t)modidx((int)t) * 6 * D + (which == 0 ? 0 : 3 * D);
        const float* sc = sh + D;
        float ss = 0.f;
        for (int k = 0; k < D; ++k) ss += x[k] * x[k];
        const float rstd = 1.f / sqrtf(ss / D + EPS);
        for (int k = 0; k < D; ++k) stf(h, (size_t)t * D + k, x[k] * rstd * g[k] * (1.f + sc[k]) + sh[k]);
    }
}
template <typename TA>
DEVFN void gemm4x4(const TA* A, size_t lda, const float* B, size_t ldb, int K, int r0, int c0, float (&acc)[4][4]) {
#pragma unroll
    for (int i = 0; i < 4; ++i)
#pragma unroll
        for (int j = 0; j < 4; ++j) acc[i][j] = 0.f;
    for (int k = 0; k < K; ++k) {
        float a[4], b[4];
#pragma unroll
        for (int i = 0; i < 4; ++i) a[i] = ldf(A, (size_t)(r0 + i) * lda + k);
#pragma unroll
        for (int j = 0; j < 4; ++j) b[j] = B[(size_t)k * ldb + c0 + j];
#pragma unroll
        for (int i = 0; i < 4; ++i)
#pragma unroll
            for (int j = 0; j < 4; ++j) acc[i][j] += a[i] * b[j];
    }
}
DEVFN void n2_proj(const Prm& p, long gtid, long gn) {
    const h_t* h = (const h_t*)(p.ws + WS_H);
    proj_t* proj = (proj_t*)(p.ws + WS_PROJ);
    constexpr int NC = IN_W / 4;
    for (long i = gtid; i < (long)(T / 4) * NC; i += gn) {
        const int r0 = (int)(i / NC) * 4, c0 = (int)(i % NC) * 4;
        float acc[4][4];
        gemm4x4(h, D, p.w_in + (wsrc_col(c0) - c0), IN_W, D, r0, c0, acc);
#pragma unroll
        for (int a = 0; a < 4; ++a)
#pragma unroll
            for (int b = 0; b < 4; ++b) stf(proj, (size_t)(r0 + a) * IN_W + c0 + b, acc[a][b]);
    }
}
DEVFN void n3_qk(const Prm& p, long gtid, long gn) {
    const proj_t* proj = (const proj_t*)(p.ws + WS_PROJ);
    qk_t* qn = (qk_t*)(p.ws + WS_QK);
    qk_t* kn = qn + (size_t)T * 512;
    for (long i = gtid; i < (long)T * 12; i += gn) {
        const int t = (int)(i / 12), hh = (int)(i % 12);
        int s, pos; tokinfo(t, s, pos);
        if (hh >= 10) {
            if (t < TP) { const int kvh = hh - 10;
                for (int d = 0; d < 64; ++d) p.out[O_V + ((size_t)t * 2 + kvh) * 64 + d] = ldf(proj, (size_t)t * IN_W + C_AV + kvh * 64 + d); }
            continue;
        }
        const bool isq = hh < 8;
        const int col = isq ? C_AQ + hh * 64 : C_AK + (hh - 8) * 64;
        const float* g = isq ? p.q_norm_g : p.k_norm_g;
        float v[64]; float ss = 0.f;
#pragma unroll
        for (int d = 0; d < 64; ++d) { v[d] = ldf(proj, (size_t)t * IN_W + col + d); ss += v[d] * v[d]; }
        const float rstd = 1.f / sqrtf(ss / 64.f + EPS);
#pragma unroll
        for (int d = 0; d < 64; ++d) v[d] = v[d] * rstd * g[d];
        if (!isq && t < TP) {
#pragma unroll
            for (int d = 0; d < 64; ++d) p.out[O_K + ((size_t)t * 2 + (hh - 8)) * 64 + d] = v[d];
        }
        if (t >= TP) {
            const float rowp = (float)(pos / GRID_W), colp = (float)(pos % GRID_W);
#pragma unroll
            for (int j = 0; j < 16; ++j) {
                const float inv = exp2f(-(float)j * (13.287712379549449f / 16.f));
                float a1 = rowp * inv, a2 = colp * inv;
                float c1 = fcos(a1), s1 = fsin(a1), c2 = fcos(a2), s2 = fsin(a2);
                float x1 = v[j], x2 = v[16 + j]; v[j] = x1 * c1 - x2 * s1; v[16 + j] = x2 * c1 + x1 * s1;
                x1 = v[32 + j]; x2 = v[48 + j]; v[32 + j] = x1 * c2 - x2 * s2; v[48 + j] = x2 * c2 + x1 * s2;
            }
        }
        qk_t* dst = isq ? qn + (size_t)t * 512 + hh * 64 : kn + (size_t)t * 128 + (hh - 8) * 64;
#pragma unroll
        for (int d = 0; d < 64; ++d) stf(dst, d, isq ? v[d] * 0.125f : v[d]);
    }
}
template <typename TK, typename TV>
DEVFN void attn_step(const float (&q)[64], float (&o)[64], float& m, float& l, const TK* kp, const TV* vp) {
    float sc = 0.f;
#pragma unroll
    for (int d = 0; d < 64; ++d) sc += q[d] * ldf(kp, d);
    const float mn = sc > m ? sc : m;
    const float alpha = expf(m - mn), pe = expf(sc - mn);
    l = l * alpha + pe;
#pragma unroll
    for (int d = 0; d < 64; ++d) o[d] = o[d] * alpha + pe * ldf(vp, d);
    m = mn;
}
DEVFN void n4_attn(const Prm& p, long gtid, long gn) {
    const proj_t* proj = (const proj_t*)(p.ws + WS_PROJ);
    const qk_t* qn = (const qk_t*)(p.ws + WS_QK);
    const qk_t* kn = qn + (size_t)T * 512;
    o_t* oa = (o_t*)(p.ws + WS_OA);
    for (long i = gtid; i < (long)T * 8; i += gn) {
        const int t = (int)(i / 8), hq = (int)(i % 8), kvh = hq / 4;
        int s, pos; tokinfo(t, s, pos);
        int start, len; seqinfo(s, start, len);
        float q[64], o[64];
#pragma unroll
        for (int d = 0; d < 64; ++d) { q[d] = ldf(qn, (size_t)t * 512 + hq * 64 + d); o[d] = 0.f; }
        float m = -1e30f, l = 0.f;
        if (t >= TP) { const int b = s - BATCH;
            for (int j = 0; j < PAST; ++j) attn_step(q, o, m, l, p.cache_k + (((size_t)b * PAST + j) * 2 + kvh) * 64, p.cache_v + (((size_t)b * PAST + j) * 2 + kvh) * 64); }
        for (int j = 0; j < len; ++j) { const int tk = start + j;
            attn_step(q, o, m, l, kn + (size_t)tk * 128 + kvh * 64, proj + (size_t)tk * IN_W + C_AV + kvh * 64); }
        const float il = 1.f / l;
#pragma unroll
        for (int d = 0; d < 64; ++d) stf(oa, (size_t)t * 512 + hq * 64 + d, o[d] * il);
    }
}
DEVFN void n5a_conv(const Prm& p, long gtid, long gn) {
    const proj_t* proj = (const proj_t*)(p.ws + WS_PROJ);
    conv_t* cv = (conv_t*)(p.ws + WS_CONV);
    for (long i = gtid; i < (long)T * 1536; i += gn) {
        const int t = (int)(i / 1536), c = (int)(i % 1536);
        int s, pos; tokinfo(t, s, pos);
        int start, len; seqinfo(s, start, len);
        float y = 0.f;
#pragma unroll
        for (int j = 0; j < 5; ++j) { const int pp = pos - 2 + j; if (pp >= 0 && pp < len) y += p.conv_w[j * 1536 + c] * ldf(proj, (size_t)(start + pp) * IN_W + C_DQ + c); }
        stf(cv, (size_t)t * 1536 + c, siluf(y));
    }
}
DEVFN void n5b_norm_gate(const Prm& p, bool do_gate, long gtid, long gn) {
    const proj_t* proj = (const proj_t*)(p.ws + WS_PROJ);
    conv_t* cv = (conv_t*)(p.ws + WS_CONV);
    float* gb = (float*)(p.ws + WS_GB);
    for (long i = gtid; i < (long)T * 32; i += gn) {
        const int t = (int)(i / 32), hh = (int)(i % 32);
        if (hh < 16) {
            float ss = 0.f;
            for (int d = 0; d < 64; ++d) { const float v = ldf(cv, (size_t)t * 1536 + hh * 64 + d); ss += v * v; }
            const float r = 1.f / sqrtf(ss + EPS);
            for (int d = 0; d < 64; ++d) { const float v = ldf(cv, (size_t)t * 1536 + hh * 64 + d); stf(cv, (size_t)t * 1536 + hh * 64 + d, v * r); }
        } else if (do_gate) {
            const int j = hh - 16;
            gb[(size_t)t * 32 + 16 + j] = sigmf(ldf(proj, (size_t)t * IN_W + C_BETA + j));
            gb[(size_t)t * 32 + j] = -expf(p.a_log[j]) * softplusf(ldf(proj, (size_t)t * IN_W + C_ALPHA + j) + p.dt_bias[j]);
        }
    }
}
DEVFN void n6_scan(const Prm& p, long gtid, long gn) {
    const conv_t* cv = (const conv_t*)(p.ws + WS_CONV);
    const float* gb = (const float*)(p.ws + WS_GB);
    float* odir0 = (float*)(p.ws + WS_H); float* odir1 = (float*)(p.ws + WS_OD1);
    for (long i = gtid; i < (long)NSEQ * 8 * 2 * 64; i += gn) {
        const int e = (int)(i % 64), dir = (int)((i / 64) % 2), h = (int)((i / 128) % 8), s = (int)(i / 1024);
        int start, len; seqinfo(s, start, len);
        float S[64];
        if (s >= BATCH) { const float* s0 = (dir == 0 ? p.state_fwd : p.state_bwd) + ((size_t)(s - BATCH) * 8 + h) * 4096;
#pragma unroll
            for (int d = 0; d < 64; ++d) S[d] = s0[d * 64 + e];
        } else {
#pragma unroll
            for (int d = 0; d < 64; ++d) S[d] = 0.f;
        }
        for (int ii = 0; ii < len; ++ii) {
            const int tok = dir == 0 ? start + ii : start + len - 1 - ii;
            const float a = expf(gb[(size_t)tok * 32 + dir * 8 + h]), beta = gb[(size_t)tok * 32 + 16 + dir * 8 + h];
            const conv_t* qp = cv + (size_t)tok * 1536 + h * 64;
            const conv_t* kp = qp + 512;
            const float ve = ldf(cv, (size_t)tok * 1536 + 1024 + h * 64 + e);
            float kS = 0.f;
#pragma unroll
            for (int dg = 0; dg < 4; ++dg) {
#pragma unroll
                for (int d = dg * 16; d < dg * 16 + 16; ++d) { S[d] *= a; kS += ldf(kp, d) * S[d]; }
#ifndef HOST_EMU
                asm volatile("" ::: "memory");
#endif
            }
            const float dl = beta * (ve - kS);
            float o = 0.f;
#pragma unroll
            for (int dg = 0; dg < 4; ++dg) {
#pragma unroll
                for (int d = dg * 16; d < dg * 16 + 16; ++d) { S[d] += ldf(kp, d) * dl; o += ldf(qp, d) * S[d]; }
#ifndef HOST_EMU
                asm volatile("" ::: "memory");
#endif
            }
            (dir == 0 ? odir0 : odir1)[(size_t)tok * 512 + h * 64 + e] = o * 0.125f;
        }
        if (s < BATCH) { float* so = p.out + (dir == 0 ? O_SF : O_SB) + ((size_t)s * 8 + h) * 4096;
#pragma unroll
            for (int d = 0; d < 64; ++d) so[d * 64 + e] = S[d];
        }
    }
}
DEVFN void n7_dnout(const Prm& p, long gtid, long gn) {
    const proj_t* proj = (const proj_t*)(p.ws + WS_PROJ);
    const float* odir0 = (const float*)(p.ws + WS_H); const float* odir1 = (const float*)(p.ws + WS_OD1);
    o_t* od = (o_t*)(p.ws + WS_OD);
    for (long i = gtid; i < (long)T * 8; i += gn) {
        const int t = (int)(i / 8), h = (int)(i % 8);
        float ss = 0.f;
        for (int e = 0; e < 64; ++e) { const float v = odir0[(size_t)t * 512 + h * 64 + e] + odir1[(size_t)t * 512 + h * 64 + e]; ss += v * v; }
        const float r = 1.f / sqrtf(ss / 64.f + EPS);
        for (int e = 0; e < 64; ++e) { const float v = odir0[(size_t)t * 512 + h * 64 + e] + odir1[(size_t)t * 512 + h * 64 + e];
            stf(od, (size_t)t * 512 + h * 64 + e, v * r * p.dn_norm_g[e] * siluf(ldf(proj, (size_t)t * IN_W + C_DZ + h * 64 + e))); }
    }
}
DEVFN void n8_merge(const Prm& p, long gtid, long gn) {
    const proj_t* proj = (const proj_t*)(p.ws + WS_PROJ);
    const o_t* oa = (const o_t*)(p.ws + WS_OA);
    const o_t* od = (const o_t*)(p.ws + WS_OD);
    o_t* mg = (o_t*)(p.ws + WS_MG);
    constexpr int NC = D / 4;
    for (long i = gtid; i < (long)(T / 4) * NC; i += gn) {
        const int r0 = (int)(i / NC) * 4, c0 = (int)(i % NC) * 4;
        float a1[4][4], a2[4][4];
        gemm4x4(oa, 512, p.w_pa, D, 512, r0, c0, a1);
        gemm4x4(od, 512, p.w_pb, D, 512, r0, c0, a2);
#pragma unroll
        for (int a = 0; a < 4; ++a)
#pragma unroll
            for (int b = 0; b < 4; ++b) { const size_t t = r0 + a; const int j = c0 + b;
                stf(mg, t * D + j, sigmf(ldf(proj, t * IN_W + C_GA + j)) * a1[a][b] + sigmf(ldf(proj, t * IN_W + C_GB + j)) * a2[a][b]); }
    }
}
DEVFN void n9_wo(const Prm& p, long gtid, long gn) {
    const o_t* mg = (const o_t*)(p.ws + WS_MG);
    const float* mod = (const float*)(p.ws + WS_MOD);
    constexpr int NC = D / 4;
    for (long i = gtid; i < (long)(T / 4) * NC; i += gn) {
        const int r0 = (int)(i / NC) * 4, c0 = (int)(i % NC) * 4;
        float acc[4][4];
        gemm4x4(mg, D, p.w_o, D, D, r0, c0, acc);
#pragma unroll
        for (int a = 0; a < 4; ++a)
#pragma unroll
            for (int b = 0; b < 4; ++b) { const int t = r0 + a, j = c0 + b;
                p.out[O_Y + (size_t)t * D + j] = xrow(p, t)[j] + mod[(size_t)modidx(t) * 6 * D + 2 * D + j] * acc[a][b]; }
    }
}
DEVFN void n11_ffn_up(const Prm& p, long gtid, long gn) {
    const h_t* h = (const h_t*)(p.ws + WS_H);
    act_t* act = (act_t*)(p.ws + WS_PROJ);
    constexpr int NC = FF / 4;
    for (long i = gtid; i < (long)(T / 4) * NC; i += gn) {
        const int r0 = (int)(i / NC) * 4, c0 = (int)(i % NC) * 4;
        float a1[4][4], a2[4][4];
        gemm4x4(h, D, p.w_gate, FF, D, r0, c0, a1);
        gemm4x4(h, D, p.w_up, FF, D, r0, c0, a2);
#pragma unroll
        for (int a = 0; a < 4; ++a)
#pragma unroll
            for (int b = 0; b < 4; ++b) stf(act, (size_t)(r0 + a) * FF + c0 + b, siluf(a1[a][b]) * a2[a][b]);
    }
}
DEVFN void n12_ffn_down(const Prm& p, long gtid, long gn) {
    const act_t* act = (const act_t*)(p.ws + WS_PROJ);
    const float* mod = (const float*)(p.ws + WS_MOD);
    constexpr int NC = D / 4;
    for (long i = gtid; i < (long)(T / 4) * NC; i += gn) {
        const int r0 = (int)(i / NC) * 4, c0 = (int)(i % NC) * 4;
        float acc[4][4];
        gemm4x4(act, FF, p.w_down, D, FF, r0, c0, acc);
#pragma unroll
        for (int a = 0; a < 4; ++a)
#pragma unroll
            for (int b = 0; b < 4; ++b) { const int t = r0 + a, j = c0 + b;
                p.out[O_Y + (size_t)t * D + j] += mod[(size_t)modidx(t) * 6 * D + 5 * D + j] * acc[a][b]; }
    }
}

#ifndef HOST_EMU
namespace pg8 {
#define PG8_LAS __attribute__((address_space(3)))
typedef unsigned short bf16_t;
typedef short bf16x8 __attribute__((ext_vector_type(8)));
typedef float f32x4 __attribute__((ext_vector_type(4)));
typedef unsigned u32x4 __attribute__((ext_vector_type(4)));
constexpr int BM = 256, BK = 64, HALF = 128, HTB = HALF * BK * 2  , STAGE_BYTES = 8 * HTB, NXCD = 8, WGM = 8;

__host__ __device__ __forceinline__ int lds_byte(int r, int c) { const int st = (r >> 4) * 2 + (c >> 5), rr = r & 15, cc = c & 31, ob = rr * 64 + cc * 2; return st * 1024 + (ob ^ (((ob >> 9) & 1) << 5)); }
__host__ __device__ __forceinline__ void stage_rc(int b, int& R, int& C) { const int st = b / 1024, sb = b % 1024, swz = sb ^ (((sb >> 9) & 1) << 5); R = (st >> 1) * 16 + swz / 64; C = (st & 1) * 32 + (swz % 64) / 2; }
__host__ __device__ __forceinline__ int perm32(int rho) { const int n = rho >> 4, i = rho & 15; return 8 * (i >> 2) + 4 * n + (i & 3); }

struct Unit { int pm, pn, kind; };
struct Gemm { const bf16_t* A; const bf16_t* Bt; int M, N, K; const bf16_t* A2; const bf16_t* Bt2; };

struct StaticOrder {
    int nM, nN, nwg, G, c;
    __host__ __device__ void init(int M, int N, int G_, int c_) { nM = M / BM; nN = N / BM; nwg = nM * nN; G = G_; c = c_; }
    __host__ __device__ bool next(int i, Unit& u) const {
        const long L = (long)i * G + c; if (L >= nwg) return false;
        int wgid = (int)L; { const int q = nwg / NXCD, r = nwg % NXCD, xcd = wgid % NXCD, off = wgid / NXCD; wgid = (xcd < r ? xcd * (q + 1) : r * (q + 1) + (xcd - r) * q) + off; }
        const int nig = WGM * nN, gid = wgid / nig, fm = gid * WGM, gsz = (nM - fm) < WGM ? (nM - fm) : WGM;
        u.pm = fm + ((wgid % nig) % gsz); u.pn = (wgid % nig) / gsz; u.kind = 0; return true;
    }
    __device__ __forceinline__ void a_ready(const Unit&) const {}
    __device__ __forceinline__ void done(const Unit&) const {}
};

typedef float f32x2_ __attribute__((ext_vector_type(2)));
typedef __bf16 bf16x2_ __attribute__((ext_vector_type(2)));
__device__ __forceinline__ unsigned cvt_pk_bf16(float lo, float hi) { const f32x2_ v = {lo, hi}; return __builtin_bit_cast(unsigned, __builtin_convertvector(v, bf16x2_)); }
typedef float f32x2 __attribute__((ext_vector_type(2)));

__device__ __forceinline__ void unpack8(u32x4 w, float (&f)[8]) {
    f[0] = __uint_as_float(w.x << 16); f[1] = __uint_as_float(w.x & 0xffff0000u); f[2] = __uint_as_float(w.y << 16); f[3] = __uint_as_float(w.y & 0xffff0000u);
    f[4] = __uint_as_float(w.z << 16); f[5] = __uint_as_float(w.z & 0xffff0000u); f[6] = __uint_as_float(w.w << 16); f[7] = __uint_as_float(w.w & 0xffff0000u);
}
__device__ __forceinline__ u32x4 pack8(const float (&f)[8]) { u32x4 w; w.x = cvt_pk_bf16(f[0], f[1]); w.y = cvt_pk_bf16(f[2], f[3]); w.z = cvt_pk_bf16(f[4], f[5]); w.w = cvt_pk_bf16(f[6], f[7]); return w; }
__device__ __forceinline__ float sigm_(float x) { return __builtin_amdgcn_rcpf(1.f + __expf(-x)); }
struct EpiStore {
    static constexpr bool PERM = true, AFTER_DRAIN = false, TWO_STAGE = false;
    bf16_t* O; int ldc;
    __device__ __forceinline__ void operator()(const f32x4 (&acc)[2][2][4][2], const Unit& u, int wr, int wc, int fr, int fq) const {
        const int row0 = u.pm * BM + wr * 64 + fr, col0 = u.pn * BM + wc * 32 + 8 * fq;
#pragma unroll
        for (int ai = 0; ai < 2; ++ai)
#pragma unroll
            for (int m = 0; m < 4; ++m) { bf16_t* rowp = O + (size_t)(row0 + ai * HALF + m * 16) * ldc + col0;
#pragma unroll
                for (int bj = 0; bj < 2; ++bj) { const f32x4 v0 = acc[ai][bj][m][0], v1 = acc[ai][bj][m][1];
                    u32x4 w; w.x = cvt_pk_bf16(v0[0], v0[1]); w.y = cvt_pk_bf16(v0[2], v0[3]); w.z = cvt_pk_bf16(v1[0], v1[1]); w.w = cvt_pk_bf16(v1[2], v1[3]);
                    *(u32x4*)(rowp + bj * HALF) = w; } }
    }
};
struct EpiMerge {
    static constexpr bool PERM = true, AFTER_DRAIN = false, TWO_STAGE = true;
    bf16_t* O; int ldo; const bf16_t* Ga; const bf16_t* Gb; int ldg;
    __device__ __forceinline__ void mid(f32x4 (&acc)[2][2][4][2], const Unit& u, int wr, int wc, int fr, int fq) const {
        const int row0 = u.pm * BM + wr * 64 + fr, col0 = u.pn * BM + wc * 32 + 8 * fq;
#pragma unroll
        for (int am = 0; am < 4; ++am) { const int ai = am >> 1, m0 = (am & 1) * 2; u32x4 ra[2][2], rb[2][2];
#pragma unroll
            for (int m = 0; m < 2; ++m)
#pragma unroll
                for (int bj = 0; bj < 2; ++bj) { const size_t off = (size_t)(row0 + ai * HALF + (m0 + m) * 16) * ldg + col0 + bj * HALF; ra[m][bj] = *(const u32x4*)(Ga + off); rb[m][bj] = *(const u32x4*)(Gb + off); }
#pragma unroll
            for (int m = 0; m < 2; ++m)
#pragma unroll
                for (int bj = 0; bj < 2; ++bj) { float ga[8], gb[8]; unpack8(ra[m][bj], ga); unpack8(rb[m][bj], gb);
#pragma unroll
                    for (int j = 0; j < 8; ++j) acc[ai][bj][m0 + m][j >> 2][j & 3] *= (1.f + __expf(-fmaxf(ga[j], -80.f))) * __builtin_amdgcn_rcpf(1.f + __expf(-gb[j])); } }
    }
    __device__ __forceinline__ void operator()(const f32x4 (&acc)[2][2][4][2], const Unit& u, int wr, int wc, int fr, int fq) const {
        const int row0 = u.pm * BM + wr * 64 + fr, col0 = u.pn * BM + wc * 32 + 8 * fq;
#pragma unroll
        for (int ai = 0; ai < 2; ++ai) { u32x4 ra[4][2];
#pragma unroll
            for (int m = 0; m < 4; ++m)
#pragma unroll
                for (int bj = 0; bj < 2; ++bj) ra[m][bj] = *(const u32x4*)(Ga + (size_t)(row0 + ai * HALF + m * 16) * ldg + col0 + bj * HALF);
#pragma unroll
            for (int m = 0; m < 4; ++m)
#pragma unroll
                for (int bj = 0; bj < 2; ++bj) { float ga[8], o[8]; unpack8(ra[m][bj], ga);
#pragma unroll
                    for (int j = 0; j < 8; ++j) o[j] = acc[ai][bj][m][j >> 2][j & 3] * __builtin_amdgcn_rcpf(1.f + __expf(-fmaxf(ga[j], -80.f)));
                    *(u32x4*)(O + (size_t)(row0 + ai * HALF + m * 16) * ldo + col0 + bj * HALF) = pack8(o); } }
    }
};
struct EpiResidA {
    static constexpr bool PERM = true, AFTER_DRAIN = false, TWO_STAGE = false;
    const float* xp; const float* xs; bf16_t* X1; const float* mod; int gate_off;
    __device__ __forceinline__ void operator()(const f32x4 (&acc)[2][2][4][2], const Unit& u, int wr, int wc, int fr, int fq) const {
        const int t0 = u.pm * BM; const int row0 = t0 + wr * 64 + fr, col0 = u.pn * BM + wc * 32 + 8 * fq;
        const float* gate = mod + (size_t)modidx(t0) * 6 * D + gate_off;
        const float* base = t0 < TP ? xp : xs - (size_t)TP * D;
        f32x4 gv[2][2];
#pragma unroll
        for (int bj = 0; bj < 2; ++bj)
#pragma unroll
            for (int n = 0; n < 2; ++n) gv[bj][n] = *(const f32x4*)(gate + col0 + bj * HALF + 4 * n);
#pragma unroll
        for (int am = 0; am < 4; ++am) { const int ai = am >> 1, m0 = (am & 1) * 2; f32x4 bv[2][2][2];
#pragma unroll
            for (int m = 0; m < 2; ++m)
#pragma unroll
                for (int bj = 0; bj < 2; ++bj)
#pragma unroll
                    for (int n = 0; n < 2; ++n) bv[m][bj][n] = *(const f32x4*)(base + (size_t)(row0 + ai * HALF + (m0 + m) * 16) * D + col0 + bj * HALF + 4 * n);
#pragma unroll
            for (int m = 0; m < 2; ++m)
#pragma unroll
                for (int bj = 0; bj < 2; ++bj) { const f32x4 y0 = bv[m][bj][0] + gv[bj][0] * acc[ai][bj][m0 + m][0], y1 = bv[m][bj][1] + gv[bj][1] * acc[ai][bj][m0 + m][1];
                    u32x4 w; w.x = cvt_pk_bf16(y0[0], y0[1]); w.y = cvt_pk_bf16(y0[2], y0[3]); w.z = cvt_pk_bf16(y1[0], y1[1]); w.w = cvt_pk_bf16(y1[2], y1[3]);
                    *(u32x4*)(X1 + (size_t)(row0 + ai * HALF + (m0 + m) * 16) * D + col0 + bj * HALF) = w; } }
    }
};
struct EpiResidB {
    static constexpr bool PERM = true, AFTER_DRAIN = false, TWO_STAGE = false;
    const bf16_t* X1; float* out; const float* mod; int gate_off;
    __device__ __forceinline__ void operator()(const f32x4 (&acc)[2][2][4][2], const Unit& u, int wr, int wc, int fr, int fq) const {
        const int t0 = u.pm * BM; const int row0 = t0 + wr * 64 + fr, col0 = u.pn * BM + wc * 32 + 8 * fq;
        const float* gate = mod + (size_t)modidx(t0) * 6 * D + gate_off;
        f32x4 gv[2][2];
#pragma unroll
        for (int bj = 0; bj < 2; ++bj)
#pragma unroll
            for (int n = 0; n < 2; ++n) gv[bj][n] = *(const f32x4*)(gate + col0 + bj * HALF + 4 * n);
#pragma unroll
        for (int ai = 0; ai < 2; ++ai) { u32x4 bv[4][2];
#pragma unroll
            for (int m = 0; m < 4; ++m)
#pragma unroll
                for (int bj = 0; bj < 2; ++bj) bv[m][bj] = *(const u32x4*)(X1 + (size_t)(row0 + ai * HALF + m * 16) * D + col0 + bj * HALF);
#pragma unroll
            for (int m = 0; m < 4; ++m)
#pragma unroll
                for (int bj = 0; bj < 2; ++bj) { float b[8]; unpack8(bv[m][bj], b);
                    const f32x4 b0 = {b[0], b[1], b[2], b[3]}, b1 = {b[4], b[5], b[6], b[7]};
                    float* op = out + (size_t)(row0 + ai * HALF + m * 16) * D + col0 + bj * HALF;
                    *(f32x4*)op = b0 + gv[bj][0] * acc[ai][bj][m][0]; *(f32x4*)(op + 4) = b1 + gv[bj][1] * acc[ai][bj][m][1]; } }
    }
};
struct EpiSwiglu {
    static constexpr bool PERM = true, AFTER_DRAIN = false, TWO_STAGE = false;
    bf16_t* O;
    __device__ __forceinline__ void operator()(const f32x4 (&acc)[2][2][4][2], const Unit& u, int wr, int wc, int fr, int fq) const {
        const int row0 = u.pm * BM + wr * 64 + fr, col0 = u.pn * HALF + wc * 32 + 8 * fq;
#pragma unroll
        for (int ai = 0; ai < 2; ++ai)
#pragma unroll
            for (int m = 0; m < 4; ++m) { float o[8];
#pragma unroll
                for (int j = 0; j < 8; ++j) { const float g = acc[ai][0][m][j >> 2][j & 3], uu = acc[ai][1][m][j >> 2][j & 3]; o[j] = g * sigm_(g) * uu; }
                *(u32x4*)(O + (size_t)(row0 + ai * HALF + m * 16) * FF + col0) = pack8(o); }
    }
};
template <class Epi, class Sched, bool ALIGN_EPI = false, bool SP2 = false>
__device__ __forceinline__ void gemm_phase(PG8_LAS unsigned char* lds, const Gemm g, const Sched& S, const Epi& E) {
    const int tid = threadIdx.x, wid = __builtin_amdgcn_readfirstlane(tid >> 6), lane = tid & 63, wr = wid >> 2, wc = wid & 3, fr = lane & 15, fq = lane >> 4;
    const int K = g.K, nt = K / BK;
    unsigned voffA[2], voffB[2];
#pragma unroll
    for (int i = 0; i < 2; ++i) { int R, C; stage_rc(tid * 16 + i * 8192, R, C); const int Rb = Epi::PERM ? ((R & ~31) + perm32(R & 31)) : R;
        voffA[i] = (unsigned)(R * K + C) * 2u; voffB[i] = (unsigned)(Rb * K + C) * 2u; }
    const size_t kstep = (size_t)(BK * 2);
    const size_t hstep = (size_t)HALF * K * 2;
    const size_t tstep = 2 * hstep;
    const unsigned ldsw = (unsigned)wid * 1024u;
    const int aoff = lds_byte(wr * 64 + fr, fq * 8), boff = lds_byte(wc * 32 + fr, fq * 8);
#define PG8_SA(b, h) (((b) * 2 + (h)) * HTB)
#define PG8_SB(b, h) ((4 + (b) * 2 + (h)) * HTB)
#define PG8_STAGE(bufoff, gbase, voff) do { _Pragma("unroll") for (int _i = 0; _i < 2; ++_i) \
        __builtin_amdgcn_global_load_lds((const unsigned*)((const char*)(gbase) + (voff)[_i]), (PG8_LAS unsigned*)(lds + (bufoff) + ldsw + _i * 8192), 16, 0, 0); } while (0)
#define PG8_LDA(dst, b, h) do { _Pragma("unroll") for (int m = 0; m < 4; ++m) _Pragma("unroll") for (int k = 0; k < 2; ++k) dst[m][k] = *(const PG8_LAS bf16x8*)(lds + PG8_SA(b, h) + aoff + m * 2048 + k * 1024); } while (0)
#define PG8_LDB(dst, b, h) do { _Pragma("unroll") for (int n = 0; n < 2; ++n) _Pragma("unroll") for (int k = 0; k < 2; ++k) dst[n][k] = *(const PG8_LAS bf16x8*)(lds + PG8_SB(b, h) + boff + n * 2048 + k * 1024); } while (0)
#define PG8_MMA(ai, bj, At, Bt) do { __builtin_amdgcn_s_setprio(1); _Pragma("unroll") for (int m = 0; m < 4; ++m) _Pragma("unroll") for (int n = 0; n < 2; ++n) _Pragma("unroll") for (int k = 0; k < 2; ++k) \
        acc[ai][bj][m][n] = __builtin_amdgcn_mfma_f32_16x16x32_bf16(Bt[n][k], At[m][k], acc[ai][bj][m][n], 0, 0, 0); __builtin_amdgcn_s_setprio(0); } while (0)
#define PG8_WAIT_V(n) asm volatile("s_waitcnt vmcnt(" #n ")" ::: "memory")
#define PG8_WAIT_L(n) asm volatile("s_waitcnt lgkmcnt(" #n ")" ::: "memory")
#define PG8_BAR __builtin_amdgcn_s_barrier()
#define PG8_SCHED __builtin_amdgcn_sched_barrier(0)
    Unit cur, nxt; int ui = 0;
    if (!S.next(0, cur)) return;
    f32x4 acc[2][2][4][2];
#pragma unroll
    for (int a = 0; a < 2; ++a)
#pragma unroll
        for (int b = 0; b < 2; ++b)
#pragma unroll
            for (int m = 0; m < 4; ++m)
#pragma unroll
                for (int n = 0; n < 2; ++n) acc[a][b][m][n] = (f32x4){0.f, 0.f, 0.f, 0.f};
    bf16x8 At[4][2], B0[2][2], B1[2][2];
    const char* cA = (const char*)(cur.kind ? g.A2 : g.A) + (size_t)cur.pm * tstep; const char* cB = (const char*)(cur.kind ? g.Bt2 : g.Bt) + (size_t)cur.pn * tstep;
    S.a_ready(cur);
    if constexpr (SP2) {
        PG8_STAGE(PG8_SB(0, 0), cB, voffB); PG8_STAGE(PG8_SB(0, 1), cB + hstep, voffB); PG8_STAGE(PG8_SA(0, 0), cA, voffA); PG8_STAGE(PG8_SA(0, 1), cA + hstep, voffA);
        if (wr == 1) PG8_BAR;
        PG8_WAIT_V(2); PG8_BAR;
        PG8_STAGE(PG8_SB(1, 0), cB + kstep, voffB); PG8_STAGE(PG8_SA(1, 0), cA + kstep, voffA); PG8_STAGE(PG8_SB(1, 1), cB + hstep + kstep, voffB);
        PG8_WAIT_V(6); PG8_BAR;
    } else {
        PG8_STAGE(PG8_SB(0, 0), cB, voffB); PG8_STAGE(PG8_SA(0, 0), cA, voffA); PG8_STAGE(PG8_SB(0, 1), cB + hstep, voffB); PG8_STAGE(PG8_SA(0, 1), cA + hstep, voffA);
        if (wr == 1) PG8_BAR;
        PG8_WAIT_V(4); PG8_BAR;
        PG8_STAGE(PG8_SB(1, 0), cB + kstep, voffB); PG8_STAGE(PG8_SA(1, 0), cA + kstep, voffA); PG8_STAGE(PG8_SB(1, 1), cB + hstep + kstep, voffB);
        PG8_WAIT_V(6); PG8_BAR;
    }
    for (;;) {
        const bool has_next = S.next(ui + 1, nxt);
        const char* nA = has_next ? (const char*)(nxt.kind ? g.A2 : g.A) + (size_t)nxt.pm * tstep : cA; const char* nB = has_next ? (const char*)(nxt.kind ? g.Bt2 : g.Bt) + (size_t)nxt.pn * tstep : cB;
        for (int t = 0; t < nt; t += 2) {
            const bool last = (t == nt - 2);
            const char* a1 = cA + (size_t)(t + 1) * kstep;
            const char* a2 = last ? nA : cA + (size_t)(t + 2) * kstep; const char* b2 = last ? nB : cB + (size_t)(t + 2) * kstep;
            const char* a3 = a2 + kstep; const char* b3 = b2 + kstep;
            if (last && has_next) S.a_ready(nxt);
            if constexpr (SP2) {
            PG8_LDB(B0, 0, 0); PG8_LDB(B1, 0, 1); PG8_SCHED; PG8_LDA(At, 0, 0); PG8_STAGE(PG8_SA(1, 1), a1 + hstep, voffA);
            PG8_WAIT_V(8); PG8_WAIT_L(0); PG8_BAR; PG8_MMA(0, 0, At, B0); PG8_MMA(0, 1, At, B1); PG8_BAR; PG8_SCHED;
            PG8_LDA(At, 0, 1); PG8_STAGE(PG8_SB(0, 0), b2, voffB); PG8_STAGE(PG8_SB(0, 1), b2 + hstep, voffB); PG8_STAGE(PG8_SA(0, 0), a2, voffA);
            PG8_WAIT_V(8); PG8_WAIT_L(0); PG8_BAR; PG8_MMA(1, 0, At, B0); PG8_MMA(1, 1, At, B1); PG8_BAR; PG8_SCHED;
            PG8_LDB(B0, 1, 0); PG8_LDB(B1, 1, 1); PG8_SCHED; PG8_LDA(At, 1, 0); PG8_STAGE(PG8_SA(0, 1), a2 + hstep, voffA);
            PG8_WAIT_V(8); PG8_WAIT_L(0); PG8_BAR; PG8_MMA(0, 0, At, B0); PG8_MMA(0, 1, At, B1); PG8_BAR; PG8_SCHED;
            PG8_LDA(At, 1, 1); PG8_STAGE(PG8_SB(1, 0), b3, voffB); PG8_STAGE(PG8_SB(1, 1), b3 + hstep, voffB); PG8_STAGE(PG8_SA(1, 0), a3, voffA);
            PG8_WAIT_V(8); PG8_WAIT_L(0); PG8_BAR; PG8_MMA(1, 0, At, B0); PG8_MMA(1, 1, At, B1); PG8_BAR; PG8_SCHED;
            } else {
            PG8_LDB(B0, 0, 0); PG8_SCHED; PG8_LDA(At, 0, 0); PG8_STAGE(PG8_SA(1, 1), a1 + hstep, voffA);
            PG8_WAIT_L(8); PG8_BAR; PG8_WAIT_L(0); PG8_MMA(0, 0, At, B0); PG8_BAR; PG8_SCHED;
            PG8_LDB(B1, 0, 1); PG8_STAGE(PG8_SB(0, 0), b2, voffB);
            PG8_BAR; PG8_WAIT_L(0); PG8_MMA(0, 1, At, B1); PG8_BAR;
            PG8_LDA(At, 0, 1); PG8_STAGE(PG8_SA(0, 0), a2, voffA);
            PG8_BAR; PG8_WAIT_L(0); PG8_MMA(1, 0, At, B0); PG8_BAR; PG8_SCHED;
            PG8_STAGE(PG8_SB(0, 1), b2 + hstep, voffB);
            PG8_WAIT_V(6); PG8_BAR; PG8_MMA(1, 1, At, B1); PG8_BAR;
            PG8_LDB(B0, 1, 0); PG8_SCHED; PG8_LDA(At, 1, 0); PG8_STAGE(PG8_SA(0, 1), a2 + hstep, voffA);
            PG8_WAIT_L(8); PG8_BAR; PG8_WAIT_L(0); PG8_MMA(0, 0, At, B0); PG8_BAR; PG8_SCHED;
            PG8_LDB(B1, 1, 1); PG8_STAGE(PG8_SB(1, 0), b3, voffB);
            PG8_BAR; PG8_WAIT_L(0); PG8_MMA(0, 1, At, B1); PG8_BAR;
            PG8_LDA(At, 1, 1); PG8_STAGE(PG8_SA(1, 0), a3, voffA);
            PG8_BAR; PG8_WAIT_L(0); PG8_MMA(1, 0, At, B0); PG8_BAR; PG8_SCHED;
            PG8_STAGE(PG8_SB(1, 1), b3 + hstep, voffB);
            PG8_WAIT_V(6); PG8_BAR; PG8_MMA(1, 1, At, B1); PG8_BAR;
            }
        }
        if constexpr (ALIGN_EPI) { if (wr == 0) PG8_BAR; }
        if constexpr (Epi::TWO_STAGE) { if (cur.kind == 0) E.mid(acc, cur, wr, wc, fr, fq); else E(acc, cur, wr, wc, fr, fq); S.done(cur); }
        else if constexpr (!Epi::AFTER_DRAIN) { E(acc, cur, wr, wc, fr, fq); S.done(cur); }
        if (!has_next) break;
        if (!(Epi::TWO_STAGE && cur.kind == 0)) {
#pragma unroll
        for (int a = 0; a < 2; ++a)
#pragma unroll
            for (int b = 0; b < 2; ++b)
#pragma unroll
                for (int m = 0; m < 4; ++m)
#pragma unroll
                    for (int n = 0; n < 2; ++n) acc[a][b][m][n] = (f32x4){0.f, 0.f, 0.f, 0.f};
        }
        cur = nxt; cA = nA; cB = nB; ++ui;
        if constexpr (ALIGN_EPI) { if (wr == 1) PG8_BAR; }
    }
    PG8_WAIT_V(0);
    if constexpr (!ALIGN_EPI) { if (wr == 0) PG8_BAR; }
    PG8_BAR;
    if constexpr (Epi::AFTER_DRAIN) { E.fused(acc, cur, wr, wc, fr, fq, lds, wid, lane); S.done(cur); }
#undef PG8_SA
#undef PG8_SB
#undef PG8_STAGE
#undef PG8_LDA
#undef PG8_LDB
#undef PG8_MMA
#undef PG8_WAIT_V
#undef PG8_WAIT_L
#undef PG8_BAR
#undef PG8_SCHED
}
}

#define LAS __attribute__((address_space(3)))
typedef unsigned v4u __attribute__((ext_vector_type(4)));
typedef float f32x4 __attribute__((ext_vector_type(4)));
typedef short bf16x8 __attribute__((ext_vector_type(8)));
constexpr int NWAVES = 8, NTHREADS = NWAVES * 64;
constexpr int LDS_CTRL = 147456, LDS_BYTES = LDS_CTRL + 1024;
#define LDS_WAIT() asm volatile("s_waitcnt lgkmcnt(0)" ::: "memory")
__device__ __forceinline__ unsigned pk2(float lo, float hi) { return pg8::cvt_pk_bf16(lo, hi); }
template <int CTRL> __device__ __forceinline__ float dppf(float v) { return __builtin_bit_cast(float, __builtin_amdgcn_update_dpp(0, __builtin_bit_cast(int, v), CTRL, 0xF, 0xF, true)); }
constexpr int DPP_X1 = 0xB1, DPP_X2 = 0x4E, DPP_HM = 0x141, DPP_RM = 0x140;
__device__ __forceinline__ float red8(float v) { v += dppf<DPP_X1>(v); v += dppf<DPP_X2>(v); v += dppf<DPP_HM>(v); return v; }
__device__ __forceinline__ float red16(float v) { v = red8(v); v += dppf<DPP_RM>(v); return v; }
__device__ __forceinline__ float wave_sum(float v) { v = red16(v); v += __shfl_xor(v, 16); v += __shfl_xor(v, 32); return v; }
struct WItem { const float* src; bf16_t* dst; int ldw, ldt; };
__device__ __forceinline__ bool p0_item(const Prm& p, int it, WItem& w) {
    constexpr int I_IN = (D / 64) * (IN_W / 32), I_PA = (512 / 64) * (D / 32), I_O = (D / 64) * (D / 32), I_G = (D / 64) * (FF / 32), I_DN = (FF / 64) * (D / 32);
    constexpr int NITEMS = I_IN + 2 * I_PA + I_O + 2 * I_G + I_DN;
    if (it >= NITEMS) return false;
    int r = it;
    if (r < I_IN) { const int nb = IN_W / 32, kb = r / nb, n0 = (r % nb) * 32; const int dst = n0 < 2816 ? n0 : (n0 < 2848 ? N_MAIN + (n0 - 2816) : n0 - 32);
        w.src = p.w_in + (size_t)(kb * 64) * IN_W + n0; w.ldw = IN_W; w.dst = (bf16_t*)(p.ws + WS_WIN) + (size_t)dst * D + kb * 64; w.ldt = D; return true; } r -= I_IN;
    if (r < 2 * I_PA) { const int b = r >= I_PA; if (b) r -= I_PA; const int nb = D / 32, kb = r / nb, n0 = (r % nb) * 32;
        w.src = (b ? p.w_pb : p.w_pa) + (size_t)(kb * 64) * D + n0; w.ldw = D; w.dst = (bf16_t*)(p.ws + (b ? WS_WPB : WS_WPA)) + (size_t)n0 * 512 + kb * 64; w.ldt = 512; return true; } r -= 2 * I_PA;
    if (r < I_O) { const int nb = D / 32, kb = r / nb, n0 = (r % nb) * 32;
        w.src = p.w_o + (size_t)(kb * 64) * D + n0; w.ldw = D; w.dst = (bf16_t*)(p.ws + WS_WO) + (size_t)n0 * D + kb * 64; w.ldt = D; return true; } r -= I_O;
    if (r < 2 * I_G) { const int up = r >= I_G; if (up) r -= I_G; const int nb = FF / 32, kb = r / nb, n0 = (r % nb) * 32;
        w.src = (up ? p.w_up : p.w_gate) + (size_t)(kb * 64) * FF + n0; w.ldw = FF; w.dst = (bf16_t*)(p.ws + WS_WGU) + (size_t)((n0 / 128) * 256 + (up ? 128 : 0) + (n0 % 128)) * D + kb * 64; w.ldt = D; return true; } r -= 2 * I_G;
    { const int nb = D / 32, kb = r / nb, n0 = (r % nb) * 32;
      w.src = p.w_down + (size_t)(kb * 64) * D + n0; w.ldw = D; w.dst = (bf16_t*)(p.ws + WS_WDN) + (size_t)n0 * FF + kb * 64; w.ldt = FF; return true; }
}
__device__ __forceinline__ void p0_weights(const Prm& p, LAS float* scr, int first, int stride, int end, int lane) {
    WItem cur, nxt; float wv[32], wn[32];
    bool have = first < end && p0_item(p, first, cur);
    if (have) {
#pragma unroll
        for (int i = 0; i < 32; ++i) wv[i] = cur.src[(size_t)(2 * i + (lane >> 5)) * cur.ldw + (lane & 31)];
    }
    for (int it = first; have; it += stride) {
        const bool hn = it + stride < end && p0_item(p, it + stride, nxt);
        if (hn) {
#pragma unroll
            for (int i = 0; i < 32; ++i) wn[i] = nxt.src[(size_t)(2 * i + (lane >> 5)) * nxt.ldw + (lane & 31)];
        }
#pragma unroll
        for (int i = 0; i < 32; ++i) scr[(2 * i + (lane >> 5)) * 33 + (lane & 31)] = wv[i];
        LDS_WAIT(); asm volatile("" ::: "memory");
        const int c = lane & 7;
#pragma unroll
        for (int j = 0; j < 4; ++j) { const int n = (lane >> 3) + 8 * j; const LAS float* s = scr + (8 * c) * 33 + n;
            v4u o; o.x = pk2(s[0 * 33], s[1 * 33]); o.y = pk2(s[2 * 33], s[3 * 33]); o.z = pk2(s[4 * 33], s[5 * 33]); o.w = pk2(s[6 * 33], s[7 * 33]);
            *(v4u*)(cur.dst + (size_t)n * cur.ldt + 8 * c) = o; }
        LDS_WAIT(); asm volatile("" ::: "memory");
        have = hn; cur = nxt;
#pragma unroll
        for (int i = 0; i < 32; ++i) wv[i] = wn[i];
    }
}
constexpr int P0_I_EARLY = (D / 64) * (IN_W / 32) + 2 * ((512 / 64) * (D / 32));
constexpr int P0_I_MID = P0_I_EARLY + (D / 64) * (D / 32) + 0 * ((D / 64) * (FF / 32));
constexpr int P0_NITEMS = P0_I_EARLY + (D / 64) * (D / 32) + 2 * ((D / 64) * (FF / 32)) + (FF / 64) * (D / 32);
constexpr int P0_I_LATE = P0_NITEMS - (FF / 64) * (D / 32);
__device__ __forceinline__ void norm_rows(const Prm& p, int which, int gw, int NGW, int lane) {
    const float* mod = (const float*)(p.ws + WS_MOD);
    bf16_t* h = (bf16_t*)(p.ws + WS_H);
    const float* g = which == 0 ? p.norm1_g : p.norm2_g;
    constexpr int NR = 5;
    for (int tb = gw * NR; tb < T; tb += NGW * NR) {
        f32x4 v[NR][4];
#pragma unroll
        for (int a = 0; a < NR; ++a) { const int t = tb + a < T ? tb + a : T - 1;
            if (which == 0) { const float* x = xrow(p, t);
#pragma unroll
                for (int j = 0; j < 4; ++j) v[a][j] = *(const f32x4*)(x + 4 * lane + 256 * j); }
            else { const bf16_t* xb = (const bf16_t*)(p.ws + WS_X1) + (size_t)t * D;
#pragma unroll
                for (int j = 0; j < 4; ++j) { const uint2 w = *(const uint2*)(xb + 4 * lane + 256 * j);
                    v[a][j] = (f32x4){__uint_as_float(w.x << 16), __uint_as_float(w.x & 0xffff0000u), __uint_as_float(w.y << 16), __uint_as_float(w.y & 0xffff0000u)}; } } }
        int mcur = __builtin_amdgcn_readfirstlane(modidx(tb));
        f32x4 A4[4], B4[4];
#define NORM_LOAD_AB(mi_) do { const float* sh_ = mod + (size_t)(mi_) * 6 * D + (which == 0 ? 0 : 3 * D); const float* sc_ = sh_ + D; _Pragma("unroll") for (int j = 0; j < 4; ++j) { const int c = 4 * lane + 256 * j; \
            const f32x4 g4 = *(const f32x4*)(g + c), sc4 = *(const f32x4*)(sc_ + c); B4[j] = *(const f32x4*)(sh_ + c); A4[j] = g4 * (1.f + sc4); } } while (0)
        NORM_LOAD_AB(mcur);
#pragma unroll
        for (int a = 0; a < NR; ++a) { const int t = tb + a; if (t >= T) break;
            const int mi = __builtin_amdgcn_readfirstlane(modidx(t));
            if (mi != mcur) { mcur = mi; NORM_LOAD_AB(mcur); }
            float ss = 0.f;
#pragma unroll
            for (int j = 0; j < 4; ++j) ss += (v[a][j].x * v[a][j].x + v[a][j].y * v[a][j].y) + (v[a][j].z * v[a][j].z + v[a][j].w * v[a][j].w);
            const float rstd = __builtin_amdgcn_rsqf(wave_sum(ss) * (1.f / D) + EPS);
#pragma unroll
            for (int j = 0; j < 4; ++j) { const int c = 4 * lane + 256 * j;
                const f32x4 y = v[a][j] * rstd * A4[j] + B4[j];
                uint2 o; o.x = pk2(y.x, y.y); o.y = pk2(y.z, y.w);
                *(uint2*)(h + (size_t)t * D + c) = o; } }
#undef NORM_LOAD_AB
    }
}
__device__ __forceinline__ void mini_gemm_gates(const Prm& p, LAS unsigned char* lds, int tid) {
    const bf16_t* A = (const bf16_t*)(p.ws + WS_H);
    const bf16_t* Bt = (const bf16_t*)(p.ws + WS_WIN) + (size_t)N_MAIN * D;
    float* gb = (float*)(p.ws + WS_GB);
    const int wave = __builtin_amdgcn_readfirstlane(tid >> 6), lane = tid & 63, fr = lane & 15, fq = lane >> 4;
    LAS float* part = (LAS float*)lds;
    const f32x4 al4 = *(const f32x4*)(p.a_log + 4 * ((tid & 63) >> 4)), db4 = *(const f32x4*)(p.dt_bias + 4 * ((tid & 63) >> 4));
    const int k0 = wave * 128;
    bf16x8 a[2][4], w[2][4];
#define MG_LOAD(u_) do { const int r0_ = (u_) * 32; _Pragma("unroll") for (int kk = 0; kk < 4; ++kk) { _Pragma("unroll") for (int i = 0; i < 2; ++i) { \
        a[i][kk] = *(const bf16x8*)(A + (size_t)(r0_ + 16 * i + fr) * D + k0 + kk * 32 + fq * 8); w[i][kk] = *(const bf16x8*)(Bt + (size_t)(16 * i + fr) * D + k0 + kk * 32 + fq * 8); } } } while (0)
    if ((int)blockIdx.x < T / 32) MG_LOAD((int)blockIdx.x);
    for (int u = blockIdx.x; u < T / 32; u += gridDim.x) {
        const int r0 = u * 32;
        f32x4 acc[2][2];
#pragma unroll
        for (int i = 0; i < 2; ++i)
#pragma unroll
            for (int j = 0; j < 2; ++j) { acc[i][j] = (f32x4){0.f, 0.f, 0.f, 0.f};
#pragma unroll
                for (int kk = 0; kk < 4; ++kk) acc[i][j] = __builtin_amdgcn_mfma_f32_16x16x32_bf16(w[j][kk], a[i][kk], acc[i][j], 0, 0, 0); }
#pragma unroll
        for (int i = 0; i < 2; ++i)
#pragma unroll
            for (int j = 0; j < 2; ++j) *(LAS f32x4*)(part + (((wave * 2 + i) * 2 + j) * 64 + lane) * 4) = acc[i][j];
        if (u + (int)gridDim.x < T / 32) MG_LOAD(u + (int)gridDim.x);
        __syncthreads();
        if (tid < 256) { const int i = tid >> 7, j = (tid >> 6) & 1, l = tid & 63;
            f32x4 sum = {0.f, 0.f, 0.f, 0.f};
#pragma unroll
            for (int wv = 0; wv < 8; ++wv) sum += *(const LAS f32x4*)(part + (((wv * 2 + i) * 2 + j) * 64 + l) * 4);
            const size_t t = (size_t)(r0 + 16 * i + (l & 15));
#pragma unroll
            for (int r = 0; r < 4; ++r) { const int cidx = 4 * (l >> 4) + r;
                if (j == 0) gb[t * 32 + 16 + cidx] = pg8::sigm_(sum[r]);
                else { const float xx = sum[r] + db4[r]; gb[t * 32 + cidx] = -__expf(al4[r]) * (xx > 20.f ? xx : __logf(1.f + __expf(xx))); } } }
        __syncthreads();
    }
#undef MG_LOAD
}
__device__ __forceinline__ float fsilu(float x) { return x * __builtin_amdgcn_rcpf(1.f + __expf(-x)); }
__device__ __forceinline__ void mod_gemv(const Prm& p, LAS unsigned char* lds, int tid) {
    static_assert(NMOD == 3 && D == 1024, "mod_gemv is written for three condition vectors of 1024");
    float* mod = (float*)(p.ws + WS_MOD);
    const int wave = __builtin_amdgcn_readfirstlane(tid >> 6), lane = tid & 63;
    LAS f32x4* part = (LAS f32x4*)lds;
    for (int it = blockIdx.x; it < 24 * 4; it += gridDim.x) {
        const int cb = it >> 2, kq = it & 3, j0 = cb * 256 + 4 * lane, kb = kq * 256 + wave * 32;
        f32x4 wr[32];
#pragma unroll
        for (int kk = 0; kk < 32; ++kk) wr[kk] = *(const f32x4*)(p.w_ada + (size_t)(kb + kk) * 6 * D + j0);
        f32x4 a0 = {0.f, 0.f, 0.f, 0.f}, a1 = a0, a2 = a0;
#pragma unroll
        for (int kk = 0; kk < 32; ++kk) { const int k = kb + kk;
            const float s0 = fsilu(p.c_ctx[k]), s1 = fsilu(p.c[k]), s2 = fsilu(p.c[D + k]);
            a0 += s0 * wr[kk]; a1 += s1 * wr[kk]; a2 += s2 * wr[kk]; }
        part[(wave * 3 + 0) * 64 + lane] = a0; part[(wave * 3 + 1) * 64 + lane] = a1; part[(wave * 3 + 2) * 64 + lane] = a2;
        __syncthreads();
        if (wave < 3) { f32x4 sum = {0.f, 0.f, 0.f, 0.f};
#pragma unroll
            for (int w = 0; w < 8; ++w) sum += part[(w * 3 + wave) * 64 + lane];
            if (kq == 0) sum += *(const f32x4*)(p.b_ada + j0);
#pragma unroll
            for (int e2 = 0; e2 < 4; ++e2) atomicAdd(mod + (size_t)wave * 6 * D + j0 + e2, sum[e2]); }
        __syncthreads();
    }
}
__device__ __forceinline__ void qk_prep(const Prm& p, int gw, int NGW, int lane) {
    const bf16_t* proj = (const bf16_t*)(p.ws + WS_PROJ);
    bf16_t* qn = (bf16_t*)(p.ws + WS_QK); bf16_t* kn = qn + (size_t)T * 512;
    const int tk = lane >> 3, l = lane & 7;
    static_assert(T % 8 == 0 && TP % 8 == 0 && DEC_SEQ % 8 == 0, "qk_prep: groups of 8 tokens inside one sequence");
    float gq[8], gk[8];
    { const f32x4 a0 = *(const f32x4*)(p.q_norm_g + 8 * l), a1 = *(const f32x4*)(p.q_norm_g + 8 * l + 4), b0 = *(const f32x4*)(p.k_norm_g + 8 * l), b1 = *(const f32x4*)(p.k_norm_g + 8 * l + 4);
#pragma unroll
      for (int j = 0; j < 4; ++j) { gq[j] = a0[j] * 0.125f; gq[4 + j] = a1[j] * 0.125f; gk[j] = b0[j]; gk[4 + j] = b1[j]; } }
    for (int tb = NGW - 1 - gw; tb < T / 8; tb += NGW) {
        const int t = tb * 8 + tk;
        v4u raw[12];
#pragma unroll
        for (int hh = 0; hh < 12; ++hh) raw[hh] = *(const v4u*)(proj + (size_t)t * IN_W + C_AQ + hh * 64 + 8 * l);
        const bool lat = tb * 8 >= TP;
        float cs[8], sn[8];
        if (lat) { const int pos = (t - TP) % DEC_SEQ; const float pc = (float)(l < 4 ? pos / GRID_W : pos % GRID_W);
#pragma unroll
            for (int j = 0; j < 8; ++j) { const float ang = pc * exp2f(-(float)(8 * (l & 1) + j) * (13.287712379549449f / 16.f)); cs[j] = __cosf(ang); sn[j] = __sinf(ang); } }
#pragma unroll
        for (int hh = 0; hh < 10; ++hh) { const bool isq = hh < 8;
            float v[8]; pg8::unpack8(raw[hh], v);
            float ss = 0.f;
#pragma unroll
            for (int j = 0; j < 8; ++j) ss += v[j] * v[j];
            ss = red8(ss);
            const float rs = __builtin_amdgcn_rsqf(ss * (1.f / 64.f) + EPS);
#pragma unroll
            for (int j = 0; j < 8; ++j) v[j] = v[j] * rs * (isq ? gq[j] : gk[j]);
            if (!isq && !lat) { float* ok = p.out + O_K + ((size_t)t * 2 + (hh - 8)) * 64 + 8 * l;
                *(f32x4*)ok = (f32x4){v[0], v[1], v[2], v[3]}; *(f32x4*)(ok + 4) = (f32x4){v[4], v[5], v[6], v[7]}; }
            if (lat) {
#pragma unroll
                for (int j = 0; j < 8; ++j) { const float pt = dppf<DPP_X2>(v[j]); v[j] = (l & 2) ? v[j] * cs[j] + pt * sn[j] : v[j] * cs[j] - pt * sn[j]; } }
            const v4u o = pg8::pack8(v);
            if (isq) *(v4u*)(qn + (size_t)t * 512 + hh * 64 + 8 * l) = o; else *(v4u*)(kn + (size_t)t * 128 + (hh - 8) * 64 + 8 * l) = o; }
        if (!lat) {
#pragma unroll
            for (int vh = 0; vh < 2; ++vh) { float v[8]; pg8::unpack8(raw[10 + vh], v); float* ov = p.out + O_V + (size_t)t * 128 + vh * 64 + 8 * l;
                *(f32x4*)ov = (f32x4){v[0], v[1], v[2], v[3]}; *(f32x4*)(ov + 4) = (f32x4){v[4], v[5], v[6], v[7]}; } }
    }
}
__device__ __forceinline__ void conv_prep(const Prm& p, int gw, int NGW, int lane) {
    const bf16_t* proj = (const bf16_t*)(p.ws + WS_PROJ);
    bf16_t* cvb = (bf16_t*)(p.ws + WS_CONV);
    for (int it = gw; it < (T / 16) * 3; it += NGW) {
        const int tb = it / 3, part = it % 3, t0 = tb * 16, ch0 = part * 512 + lane * 8;
        int s, pos0; tokinfo(t0, s, pos0); int start, len; seqinfo(s, start, len);
        float w[5][8];
#pragma unroll
        for (int j = 0; j < 5; ++j) { const f32x4 a = *(const f32x4*)(p.conv_w + j * 1536 + ch0), b = *(const f32x4*)(p.conv_w + j * 1536 + ch0 + 4);
#pragma unroll
            for (int e = 0; e < 4; ++e) { w[j][e] = a[e]; w[j][4 + e] = b[e]; } }
        const bf16_t* base = proj + (size_t)start * IN_W + C_DQ + ch0;
        pg8::u32x4 xr[20];
#pragma unroll
        for (int r = 0; r < 20; ++r) { const int pp = pos0 - 2 + r; xr[r] = (pg8::u32x4){0u, 0u, 0u, 0u}; if (pp >= 0 && pp < len) xr[r] = *(const pg8::u32x4*)(base + (size_t)pp * IN_W); }
        float xw[5][8];
#pragma unroll
        for (int r = 0; r < 4; ++r) pg8::unpack8(xr[r], xw[r]);
#pragma unroll
        for (int i = 0; i < 16; ++i) {
            pg8::unpack8(xr[i + 4], xw[(i + 4) % 5]);
            float y[8]; float ss = 0.f;
#pragma unroll
            for (int e = 0; e < 8; ++e) { float a = 0.f;
#pragma unroll
                for (int j = 0; j < 5; ++j) a += w[j][e] * xw[(i + j) % 5][e];
                y[e] = fsilu(a); ss += y[e] * y[e]; }
            if (part < 2) { ss = red8(ss); const float r = __builtin_amdgcn_rsqf(ss + EPS);
#pragma unroll
                for (int e = 0; e < 8; ++e) y[e] *= r; }
            *(pg8::u32x4*)(cvb + (size_t)(t0 + i) * 1536 + ch0) = pg8::pack8(y);
        }
    }
}
#define XB_TMO      128
#define XB_XCNT(j)  (256  + 64 * (j))
#define XB_XSUB(j)  (1280 + 64 * (j))
#define XB_XGEN(j)  (2304 + 64 * (j))
#define XB_TOP      3328
#define XB_TOPGEN   3392
#define XCD_BAR_WORDS 3456
#define XB_SPIN_CAP (1u << 18)

__device__ __forceinline__ unsigned xb_ld(unsigned* p)              { return __hip_atomic_load(p, __ATOMIC_RELAXED, __HIP_MEMORY_SCOPE_AGENT); }
__device__ __forceinline__ unsigned xb_add(unsigned* p, unsigned v) { return __hip_atomic_fetch_add(p, v, __ATOMIC_RELAXED, __HIP_MEMORY_SCOPE_AGENT); }
__device__ __forceinline__ unsigned xb_xcc_id() { return (unsigned)__builtin_amdgcn_s_getreg((3 << 11) | 20) & 0xFu; }
#define XB_SPIN(cond, bar) do { unsigned _sp = 0; while (cond) { __builtin_amdgcn_s_sleep(1); \
    if ((++_sp & 255u) == 0u) { if (xb_ld(&(bar)[XB_TMO])) break; if (_sp > XB_SPIN_CAP) { atomicAdd(&(bar)[XB_TMO], 1u); break; } } } } while (0)

struct XcdBarrier {
    unsigned* bar; unsigned x;
    volatile LAS unsigned* st;
};

__device__ __forceinline__ XcdBarrier xcd_barrier_post(unsigned* bar, volatile LAS unsigned* st) {
    XcdBarrier b; b.bar = bar; b.x = xb_xcc_id(); b.st = st;
    if (threadIdx.x == 0) (void)xb_add(&bar[XB_XCNT(b.x)], 1u);
    return b;
}
__device__ __forceinline__ void xcd_barrier_complete(unsigned* bar, unsigned x, unsigned& nloc, unsigned& nx) {
    const unsigned G = gridDim.x * gridDim.y * gridDim.z;
    unsigned sum, cnt, mine, sp = 0u;
    for (;;) {
        sum = 0u; cnt = 0u; mine = 0u;
#pragma unroll
        for (unsigned j = 0; j < 16; ++j) { const unsigned c = xb_ld(&bar[XB_XCNT(j)]); sum += c; cnt += (c > 0u) ? 1u : 0u; mine = (j == x) ? c : mine; }
        if (sum == G) break;
        __builtin_amdgcn_s_sleep(1);
        if ((++sp & 255u) == 0u) { if (xb_ld(&bar[XB_TMO])) break; if (sp > XB_SPIN_CAP) { atomicAdd(&bar[XB_TMO], 1u); break; } }
    }
    nloc = mine > 0u ? mine : 1u; nx = cnt > 0u ? cnt : 1u;
}

__device__ __forceinline__ void xcd_barrier(const XcdBarrier& b) {
    asm volatile("s_waitcnt vmcnt(0)" ::: "memory");
    __syncthreads();
    if (threadIdx.x == 0) {
        unsigned* bar = b.bar;
        __builtin_amdgcn_s_waitcnt(0);
        unsigned nloc = b.st[0], nx = b.st[1];
        if (nloc == 0u) { xcd_barrier_complete(bar, b.x, nloc, nx); b.st[0] = nloc; b.st[1] = nx; }
        const unsigned old = xb_add(&bar[XB_XSUB(b.x)], 1u);
        const unsigned gen = old / nloc;
        if (old + 1u == (gen + 1u) * nloc) {
            __builtin_amdgcn_fence(__ATOMIC_RELEASE, "agent");
            asm volatile("s_waitcnt vmcnt(0)" ::: "memory");
            (void)xb_add(&bar[XB_TOP], 1u);
            XB_SPIN(xb_ld(&bar[XB_TOP]) < (gen + 1u) * nx, bar);
            __builtin_amdgcn_fence(__ATOMIC_ACQUIRE, "agent");
            asm volatile("s_waitcnt vmcnt(0)" ::: "memory");
        } else {
            XB_SPIN(xb_ld(&bar[XB_TOP]) < (gen + 1u) * nx, bar);
            __builtin_amdgcn_fence(__ATOMIC_ACQUIRE, "agent");
            asm volatile("s_waitcnt vmcnt(0)" ::: "memory");
        }
    }
    __syncthreads();
}

namespace dn {
typedef short s16x4 __attribute__((ext_vector_type(4)));
typedef short s16x8 __attribute__((ext_vector_type(8)));
constexpr int P = 72;
constexpr int OFF_KH = 0, OFF_KT = 9216, OFF_QH = 18432, OFF_VH = 27648, OFF_LB = 36864, OFF_AB = 46080, OFF_WN = 55296,
              OFF_LD = 64512  , OFF_DV = 68864  , OFF_G = 70912, OFF_B = 71168, OFF_EG = 71424, OFF_EGL = 71680, LDS_END = 71936;
__device__ __forceinline__ unsigned cvtpk(float lo, float hi) { return pg8::cvt_pk_bf16(lo, hi); }
__device__ __forceinline__ s16x4 cvt4(f32x4 v) { uint2 u; u.x = cvtpk(v[0], v[1]); u.y = cvtpk(v[2], v[3]); return __builtin_bit_cast(s16x4, u); }
__device__ __forceinline__ f32x4 mfma16(s16x4 a, s16x4 b, f32x4 c) { return __builtin_amdgcn_mfma_f32_16x16x16bf16_1k(a, b, c, 0, 0, 0); }
__device__ __forceinline__ unsigned scale_pk(unsigned w, float s) { return cvtpk(__uint_as_float(w << 16) * s, __uint_as_float(w & 0xffff0000u) * s); }

}


namespace dw {
using dn::s16x4; using dn::s16x8; using dn::cvt4; using dn::mfma16;
__device__ __forceinline__ f32x4 mfma32(s16x8 a, s16x8 b, f32x4 c) { return __builtin_amdgcn_mfma_f32_16x16x32_bf16(a, b, c, 0, 0, 0); }
__device__ __forceinline__ s16x8 cat(s16x4 lo, s16x4 hi) { return __builtin_shufflevector(lo, hi, 0, 1, 2, 3, 4, 5, 6, 7); }
constexpr int GL_FLOATS = 5 * 64;

constexpr int NCHUNK_ = NCHUNK;
__device__ __forceinline__ int chunk_id(int unit, int n) { return unit < BATCH * 16 ? unit * (SEQ / 64) + n : BATCH * 16 * (SEQ / 64) + (unit - BATCH * 16) * (DEC_SEQ / 64) + n; }

__device__ __forceinline__ void pa_task(const Prm& p, LAS float* gl, int unit_, int n_, int lane) {
    const int unit = __builtin_amdgcn_readfirstlane(unit_), n = __builtin_amdgcn_readfirstlane(n_);
    const int q = lane >> 4, c = lane & 15, s = unit >> 4, h = (unit >> 1) & 7, dir = unit & 1;
    int start, len; seqinfo(s, start, len);
    const bf16_t* cv = (const bf16_t*)(p.ws + WS_CONV) + h * 64;
    const float* gb = (const float*)(p.ws + WS_GB);
    LAS float* Gs = gl; LAS float* Bs = gl + 64; LAS float* BEs = gl + 128;
    const f32x4 Z = {0.f, 0.f, 0.f, 0.f};
    const int ci = chunk_id(unit, n);
    v4u* slw = (v4u*)(p.ws + WS_SLW) + (size_t)ci * 512 + lane; v4u* slu = (v4u*)(p.ws + WS_SLU) + (size_t)ci * 512 + lane;
    unsigned char* sla = p.ws + WS_SLA + (size_t)(ci - CHUNK_LAT0) * SLA_BYTES;
    const int sg = dir == 0 ? 1 : -1, t0 = dir == 0 ? start + n * 64 : start + len - 1 - n * 64;
    const int rc = t0 + sg * c;
#define PA_ROWC(b_) (rc + sg * 16 * (b_))
    s16x8 kf[4][2], qfn0, qfn1;
#pragma unroll
    for (int b = 0; b < 4; ++b) { const bf16_t* rp = cv + (size_t)PA_ROWC(b) * 1536 + 8 * q;
        kf[b][0] = *(const s16x8*)(rp + 512); kf[b][1] = *(const s16x8*)(rp + 544); if (b == 0) { qfn0 = *(const s16x8*)rp; qfn1 = *(const s16x8*)(rp + 32); } }
    { const int tg = t0 + sg * lane; const float g = gb[(size_t)tg * 32 + dir * 8 + h], b = gb[(size_t)tg * 32 + 16 + dir * 8 + h];
      float G = g;
#pragma unroll
      for (int o = 1; o < 64; o <<= 1) { const float t = __shfl_up(G, o); if (lane >= o) G += t; }
      const float Gl = __shfl(G, 63), eg = __expf(G);
      Gs[lane] = G; Bs[lane] = b; BEs[lane] = b * eg;
      ((float*)(sla + 5120))[lane] = eg; ((float*)(sla + 5120))[64 + lane] = __expf(Gl - G); }
    __builtin_amdgcn_sched_barrier(0);
    s16x4 LA[4][4], dA[4];
#pragma unroll
    for (int b = 0; b < 4; ++b) {
        const s16x8 qf0 = qfn0, qf1 = qfn1;
        if (b < 3) { const bf16_t* rp = cv + (size_t)PA_ROWC(b + 1) * 1536 + 8 * q; qfn0 = *(const s16x8*)rp; qfn1 = *(const s16x8*)(rp + 32); }
        const float Gi = Gs[16 * b + c], Bi = Bs[16 * b + c];
#pragma unroll
        for (int cb = 0; cb <= b; ++cb) {
            f32x4 t = mfma32(kf[cb][0], kf[b][0], Z); t = mfma32(kf[cb][1], kf[b][1], t);
            f32x4 u = mfma32(kf[cb][0], qf0, Z); u = mfma32(kf[cb][1], qf1, u);
            const f32x4 Gj = *(const LAS f32x4*)(Gs + 16 * cb + 4 * q), Bj = *(const LAS f32x4*)(Bs + 16 * cb + 4 * q);
            f32x4 la, aa, mc, nc;
#pragma unroll
            for (int r = 0; r < 4; ++r) { const int i = 16 * b + c, j = 16 * cb + 4 * q + r;
                const float ea = __expf(fminf(Gi - Gj[r], 0.f));
                la[r] = (i > j) ? -Bi * t[r] * ea : 0.f; aa[r] = (i >= j) ? 0.125f * u[r] * ea : 0.f;
                if (cb == b) { const float eb = __expf(fminf(Gj[r] - Gi, 0.f)); mc[r] = -la[r]; nc[r] = (j > i) ? Bj[r] * t[r] * eb : 0.f; } }
            LA[b][cb] = cvt4(la);
            *(uint2*)(sla + (b * (b + 1) / 2 + cb) * 512 + lane * 8) = __builtin_bit_cast(uint2, cvt4(aa));
            if (cb == b) {
                const s16x4 m1 = cvt4(mc), n1 = cvt4(nc);
                const s16x4 m2 = cvt4(mfma16(n1, m1, Z)), n2 = cvt4(mfma16(m1, n1, Z));
                const s16x4 m4 = cvt4(mfma16(n2, m2, Z)), n4 = cvt4(mfma16(m2, n2, Z));
                const s16x4 n8 = cvt4(mfma16(m4, n4, Z));
                f32x4 P;
#pragma unroll
                for (int r = 0; r < 4; ++r) P[r] = ((4 * q + r == c) ? 1.f : 0.f) - mc[r];
                P = mfma16(n2, cvt4(P), P); P = mfma16(n4, cvt4(P), P); P = mfma16(n8, cvt4(P), P);
                dA[b] = cvt4(P); }
            __builtin_amdgcn_sched_barrier(0);
        }
    }
    s16x8 vf[4][2];
#pragma unroll
    for (int b = 0; b < 4; ++b) { const bf16_t* rp = cv + (size_t)PA_ROWC(b) * 1536 + 1024 + 8 * q; vf[b][0] = *(const s16x8*)rp; vf[b][1] = *(const s16x8*)(rp + 32); }
    s16x4 IB;
#pragma unroll
    for (int j = 0; j < 4; ++j) IB[j] = (4 * q + j == c) ? (short)0x3F80 : (short)0;
#pragma unroll
    for (int ks = 0; ks < 2; ++ks) {
        s16x4 wlo[4], whi[4];
#pragma unroll
        for (int hf = 0; hf < 2; ++hf) {
            s16x8 selh;
#pragma unroll
            for (int j = 0; j < 8; ++j) selh[j] = (8 * q + j == 16 * hf + c) ? (short)0x3F80 : (short)0;
            s16x4 xb[4];
#pragma unroll
            for (int b = 0; b < 4; ++b) { f32x4 acc = mfma32(kf[b][ks], selh, Z) * *(const LAS f32x4*)(BEs + 16 * b + 4 * q);
#pragma unroll
                for (int cb = 0; cb < b; ++cb) acc = mfma16(LA[b][cb], xb[cb], acc);
                xb[b] = cvt4(mfma16(dA[b], cvt4(acc), Z)); }
#pragma unroll
            for (int b = 0; b < 4; ++b) { const s16x4 w = cvt4(-mfma16(xb[b], IB, Z)); if (hf == 0) wlo[b] = w; else whi[b] = w; }
            s16x4 ub[4];
#pragma unroll
            for (int b = 0; b < 4; ++b) { f32x4 acc = mfma32(vf[b][ks], selh, Z) * *(const LAS f32x4*)(Bs + 16 * b + 4 * q);
#pragma unroll
                for (int cb = 0; cb < b; ++cb) acc = mfma16(LA[b][cb], ub[cb], acc);
                ub[b] = cvt4(mfma16(dA[b], cvt4(acc), Z)); }
            slu[(size_t)((2 * ks + hf) * 2 + 0) * 64] = __builtin_bit_cast(v4u, cat(ub[0], ub[1]));
            slu[(size_t)((2 * ks + hf) * 2 + 1) * 64] = __builtin_bit_cast(v4u, cat(ub[2], ub[3]));
            __builtin_amdgcn_sched_barrier(0);
        }
#pragma unroll
        for (int b = 0; b < 4; ++b) slw[(size_t)(b * 2 + ks) * 64] = __builtin_bit_cast(v4u, cat(wlo[b], whi[b]));
    }
#undef PA_ROWC
}

__device__ __forceinline__ void pb1_task(const Prm& p, int unit_, int g_, int lane) {
    const int unit = __builtin_amdgcn_readfirstlane(unit_), g = __builtin_amdgcn_readfirstlane(g_);
    const int q = lane >> 4, c = lane & 15, s = unit >> 4, h = (unit >> 1) & 7, dir = unit & 1;
    int start, len; seqinfo(s, start, len);
    const int nch = len / 64;
    const bf16_t* cv = (const bf16_t*)(p.ws + WS_CONV) + h * 64;
    const f32x4 Z = {0.f, 0.f, 0.f, 0.f};
    f32x4 S[4] = {Z, Z, Z, Z};
    if (s >= BATCH) { const float* s0 = (dir == 0 ? p.state_fwd : p.state_bwd) + ((size_t)(s - BATCH) * 8 + h) * 4096;
#pragma unroll
        for (int db = 0; db < 4; ++db)
#pragma unroll
            for (int r = 0; r < 4; ++r) S[db][r] = s0[(16 * db + 4 * q + r) * 64 + 16 * g + c]; }
    s16x8 WAn[4][2], kfn[4][2]; v4u un0, un1;
#define PB1_LOAD(n_) do { const int ci_ = chunk_id(unit, (n_)); const v4u* slw_ = (const v4u*)(p.ws + WS_SLW) + (size_t)ci_ * 512 + lane; const v4u* slu_ = (const v4u*)(p.ws + WS_SLU) + (size_t)ci_ * 512 + lane; \
        const float* gat_ = (const float*)(p.ws + WS_SLA + (size_t)(ci_ - CHUNK_LAT0) * SLA_BYTES + 5120); const int t0_ = dir == 0 ? start + (n_) * 64 : start + len - 1 - (n_) * 64; \
        _Pragma("unroll") for (int i_ = 0; i_ < 8; ++i_) WAn[i_ >> 1][i_ & 1] = __builtin_bit_cast(s16x8, slw_[(size_t)i_ * 64]); \
        un0 = slu_[(size_t)(g * 2) * 64]; un1 = slu_[(size_t)(g * 2 + 1) * 64]; \
        _Pragma("unroll") for (int b_ = 0; b_ < 4; ++b_) { const bf16_t* rp_ = cv + (size_t)(t0_ + (dir == 0 ? 1 : -1) * (16 * b_ + c)) * 1536 + 512 + 8 * q; kfn[b_][0] = *(const s16x8*)rp_; kfn[b_][1] = *(const s16x8*)(rp_ + 32); } (void)gat_; } while (0)
    PB1_LOAD(0);
#pragma unroll 1
    for (int n = 0; n < nch; ++n) {
        const int ci = chunk_id(unit, n);
        v4u* slu = (v4u*)(p.ws + WS_SLU) + (size_t)ci * 512 + lane; v4u* slv = (v4u*)(p.ws + WS_SLV) + (size_t)(ci - CHUNK_LAT0) * 512 + lane;
        s16x8 KCp[2][4];
#pragma unroll
        for (int db = 0; db < 4; ++db) { s16x8 sl;
#pragma unroll
            for (int j = 0; j < 8; ++j) sl[j] = (8 * q + j == 16 * (db & 1) + c) ? (short)0x3F80 : (short)0;
#pragma unroll
            for (int m = 0; m < 2; ++m) KCp[m][db] = cat(cvt4(mfma32(kfn[2 * m][db >> 1], sl, Z)), cvt4(mfma32(kfn[2 * m + 1][db >> 1], sl, Z))); }
        s16x8 WAp[4][2]; f32x4 egl[4];
        const float* gat = (const float*)(p.ws + WS_SLA + (size_t)(ci - CHUNK_LAT0) * SLA_BYTES + 5120);
#pragma unroll
        for (int i = 0; i < 4; ++i) { WAp[i][0] = WAn[i][0]; WAp[i][1] = WAn[i][1]; egl[i] = *(const f32x4*)(gat + 64 + 16 * i + 4 * q); }
        const v4u u0 = un0, u1 = un1; const float dl = gat[63];
        __builtin_amdgcn_sched_barrier(0);
        PB1_LOAD(n + 1 < nch ? n + 1 : n);
        __builtin_amdgcn_sched_barrier(0);
        const s16x8 sb0 = cat(cvt4(S[0]), cvt4(S[1])), sb1 = cat(cvt4(S[2]), cvt4(S[3]));
        slu[(size_t)(g * 2) * 64] = __builtin_bit_cast(v4u, sb0); slu[(size_t)(g * 2 + 1) * 64] = __builtin_bit_cast(v4u, sb1);
        s16x4 vn[4], vs[4];
#pragma unroll
        for (int tb = 0; tb < 4; ++tb) { const v4u ur = (tb >> 1) ? u1 : u0; const unsigned w0 = (tb & 1) ? ur.z : ur.x, w1 = (tb & 1) ? ur.w : ur.y;
            f32x4 acc = {__uint_as_float(w0 << 16), __uint_as_float(w0 & 0xffff0000u), __uint_as_float(w1 << 16), __uint_as_float(w1 & 0xffff0000u)};
            acc = mfma32(WAp[tb][0], sb0, acc); acc = mfma32(WAp[tb][1], sb1, acc);
            vn[tb] = cvt4(acc); vs[tb] = cvt4(acc * egl[tb]); }
        slv[(size_t)(g * 2) * 64] = __builtin_bit_cast(v4u, cat(vn[0], vn[1])); slv[(size_t)(g * 2 + 1) * 64] = __builtin_bit_cast(v4u, cat(vn[2], vn[3]));
        const s16x8 vs01 = cat(vs[0], vs[1]), vs23 = cat(vs[2], vs[3]);
#pragma unroll
        for (int db = 0; db < 4; ++db) { f32x4 acc = S[db] * dl; acc = mfma32(KCp[0][db], vs01, acc); acc = mfma32(KCp[1][db], vs23, acc); S[db] = acc; }
    }
#undef PB1_LOAD
    if (s < BATCH) { float* so = p.out + (dir == 0 ? O_SF : O_SB) + ((size_t)s * 8 + h) * 4096;
#pragma unroll
        for (int db = 0; db < 4; ++db)
#pragma unroll
            for (int r = 0; r < 4; ++r) so[(16 * db + 4 * q + r) * 64 + 16 * g + c] = S[db][r]; }
}

__device__ __forceinline__ void pc4_task(const Prm& p, int sh_, int j_, int tb_, int lane) {
    const int sh = __builtin_amdgcn_readfirstlane(sh_), j = __builtin_amdgcn_readfirstlane(j_), tbf = __builtin_amdgcn_readfirstlane(tb_);
    const int q = lane >> 4, c = lane & 15, s = sh >> 3, h = sh & 7;
    int start, len; seqinfo(s, start, len);
    const int nch = len / 64;
    const bf16_t* cv = (const bf16_t*)(p.ws + WS_CONV) + h * 64;
    const f32x4 Z = {0.f, 0.f, 0.f, 0.f};
    f32x4 O[4];
    uint2 zq[4];
    { const bf16_t* projz = (const bf16_t*)(p.ws + WS_PROJ);
#pragma unroll
      for (int g = 0; g < 4; ++g) zq[g] = *(const uint2*)(projz + (size_t)(start + 64 * j + 16 * tbf + c) * IN_W + C_DZ + h * 64 + 16 * g + 4 * q); }
    float gnv[4];
#pragma unroll
    for (int g = 0; g < 4; ++g) gnv[g] = p.dn_norm_g[16 * g + c];
#pragma unroll
    for (int dir = 1; dir >= 0; --dir) {
        const int n = dir == 0 ? j : nch - 1 - j, tb = dir == 0 ? tbf : 3 - tbf, ci = chunk_id(sh * 2 + dir, n);
        const v4u* slw = (const v4u*)(p.ws + WS_SLV) + (size_t)(ci - CHUNK_LAT0) * 512 + lane;
        const v4u* slu = (const v4u*)(p.ws + WS_SLU) + (size_t)ci * 512 + lane;
        const unsigned char* sla = p.ws + WS_SLA + (size_t)(ci - CHUNK_LAT0) * SLA_BYTES;
        const int sg = dir == 0 ? 1 : -1, t0 = dir == 0 ? start + n * 64 : start + len - 1 - n * 64;
        v4u sbr[8], vnr[8]; uint2 aar[4];
#pragma unroll
        for (int i = 0; i < 8; ++i) { sbr[i] = slu[(size_t)i * 64]; vnr[i] = slw[(size_t)i * 64]; }
#pragma unroll
        for (int tc = 0; tc < 4; ++tc) aar[tc] = *(const uint2*)(sla + ((tb * (tb + 1) / 2 + (tc <= tb ? tc : 0)) * 512) + lane * 8);
        const f32x4 eg = *(const f32x4*)((const float*)(sla + 5120) + 16 * tb + 4 * q) * 0.125f;
        const bf16_t* rp = cv + (size_t)(t0 + sg * (16 * tb + c)) * 1536 + 4 * q;
        const s16x8 qa0 = cat(*(const s16x4*)rp, *(const s16x4*)(rp + 16)), qa1 = cat(*(const s16x4*)(rp + 32), *(const s16x4*)(rp + 48));
#pragma unroll
        for (int g = 0; g < 4; ++g) {
            const s16x8 sb0 = __builtin_bit_cast(s16x8, sbr[g * 2]), sb1 = __builtin_bit_cast(s16x8, sbr[g * 2 + 1]);
            const s16x8 v01 = __builtin_bit_cast(s16x8, vnr[g * 2]), v23 = __builtin_bit_cast(s16x8, vnr[g * 2 + 1]);
            const s16x4 vn[4] = {__builtin_shufflevector(v01, v01, 0, 1, 2, 3), __builtin_shufflevector(v01, v01, 4, 5, 6, 7), __builtin_shufflevector(v23, v23, 0, 1, 2, 3), __builtin_shufflevector(v23, v23, 4, 5, 6, 7)};
            f32x4 acc = mfma32(qa0, sb0, Z); acc = mfma32(qa1, sb1, acc);
            acc = acc * eg;
#pragma unroll
            for (int tc = 0; tc < 4; ++tc) if (tc <= tb) acc = mfma16(__builtin_bit_cast(s16x4, aar[tc]), vn[tc], acc);
            if (dir == 1) {
#pragma unroll
                for (int r = 0; r < 4; ++r) O[g][r] = __shfl_xor(acc[3 - r], 48);
            } else O[g] += acc;
        }
    }
    s16x4 IB;
#pragma unroll
    for (int jx = 0; jx < 4; ++jx) IB[jx] = (4 * q + jx == c) ? (short)0x3F80 : (short)0;
    bf16_t* odp = (bf16_t*)(p.ws + WS_OD);
    f32x4 ss = Z;
#pragma unroll
    for (int g = 0; g < 4; ++g) ss += O[g] * O[g];
#pragma unroll
    for (int r = 0; r < 4; ++r) { const float v = red16(ss[r]); ss[r] = __builtin_amdgcn_rsqf(v * (1.f / 64.f) + EPS); }
    const int tok = start + 64 * j + 16 * tbf + c;
#pragma unroll
    for (int g = 0; g < 4; ++g) { const float gn = gnv[g];
        const f32x4 y = mfma16(cvt4(O[g] * ss * gn), IB, Z);
        const uint2 zz = zq[g];
        const float z0 = __uint_as_float(zz.x << 16), z1 = __uint_as_float(zz.x & 0xffff0000u), z2 = __uint_as_float(zz.y << 16), z3 = __uint_as_float(zz.y & 0xffff0000u);
        uint2 o; o.x = dn::cvtpk(y[0] * z0 * pg8::sigm_(z0), y[1] * z1 * pg8::sigm_(z1)); o.y = dn::cvtpk(y[2] * z2 * pg8::sigm_(z2), y[3] * z3 * pg8::sigm_(z3));
        *(uint2*)(odp + (size_t)tok * 512 + h * 64 + 16 * g + 4 * q) = o; }
}

constexpr int MU_SLOT = 16384, MU_GATE = 8 * MU_SLOT, MU_LDS = MU_GATE + 8 * GL_FLOATS * 4;
static_assert(SEQ == 256, "prompt_unit: 4 chunks per direction");
__device__ __forceinline__ void prompt_unit(const Prm& p, LAS unsigned char* lds, int sh_, int tid) {
    const int sh = __builtin_amdgcn_readfirstlane(sh_), wave = __builtin_amdgcn_readfirstlane(tid >> 6), lane = tid & 63, q = lane >> 4, c = lane & 15;
    const int s = sh >> 3, h = sh & 7, start = s * SEQ;
    const bf16_t* cv = (const bf16_t*)(p.ws + WS_CONV) + h * 64;
    const float* gb = (const float*)(p.ws + WS_GB);
    const f32x4 Z = {0.f, 0.f, 0.f, 0.f};
    s16x4 AAr[10];
    { const int dir = wave >> 2, n = wave & 3;
      LAS float* gl = (LAS float*)(lds + MU_GATE) + wave * GL_FLOATS;
      LAS float* Gs = gl; LAS float* Bs = gl + 64; LAS float* EGs = gl + 128; LAS float* BEs = gl + 192; LAS float* EGLs = gl + 256;
      LAS v4u* slw = (LAS v4u*)(lds + wave * MU_SLOT) + lane; LAS v4u* slu = slw + 512;
      const int sg = dir == 0 ? 1 : -1, t0 = dir == 0 ? start + n * 64 : start + SEQ - 1 - n * 64;
      const int rc = t0 + sg * c;
#define MU_ROWC(b_) (rc + sg * 16 * (b_))
      s16x8 kf[4][2], qf[4][2], vf[4][2];
#pragma unroll
      for (int b = 0; b < 4; ++b) { const bf16_t* rp = cv + (size_t)MU_ROWC(b) * 1536 + 8 * q;
          kf[b][0] = *(const s16x8*)(rp + 512); kf[b][1] = *(const s16x8*)(rp + 544); qf[b][0] = *(const s16x8*)rp; qf[b][1] = *(const s16x8*)(rp + 32); }
      { const int tg = t0 + sg * lane; const float g = gb[(size_t)tg * 32 + dir * 8 + h], b = gb[(size_t)tg * 32 + 16 + dir * 8 + h];
        float G = g;
#pragma unroll
        for (int o = 1; o < 64; o <<= 1) { const float t = __shfl_up(G, o); if (lane >= o) G += t; }
        const float Gl = __shfl(G, 63), eg = __expf(G);
        Gs[lane] = G; Bs[lane] = b; EGs[lane] = eg; BEs[lane] = b * eg; EGLs[lane] = __expf(Gl - G); }
      __builtin_amdgcn_sched_barrier(0);
      s16x4 LA[4][4], dA[4];
#pragma unroll
      for (int b = 0; b < 4; ++b) {
          const s16x8 qf0 = qf[b][0], qf1 = qf[b][1];
          if (b == 3) {
#pragma unroll
              for (int b2 = 0; b2 < 4; ++b2) { const bf16_t* rp = cv + (size_t)MU_ROWC(b2) * 1536 + 1024 + 8 * q; vf[b2][0] = *(const s16x8*)rp; vf[b2][1] = *(const s16x8*)(rp + 32); } }
          const float Gi = Gs[16 * b + c], Bi = Bs[16 * b + c];
#pragma unroll
          for (int cb = 0; cb <= b; ++cb) {
              f32x4 t = mfma32(kf[cb][0], kf[b][0], Z); t = mfma32(kf[cb][1], kf[b][1], t);
              f32x4 u = mfma32(kf[cb][0], qf0, Z); u = mfma32(kf[cb][1], qf1, u);
              const f32x4 Gj = *(const LAS f32x4*)(Gs + 16 * cb + 4 * q), Bj = *(const LAS f32x4*)(Bs + 16 * cb + 4 * q);
              f32x4 la, aa, mc, nc;
#pragma unroll
              for (int r = 0; r < 4; ++r) { const int i = 16 * b + c, j = 16 * cb + 4 * q + r;
                  const float ea = __expf(fminf(Gi - Gj[r], 0.f));
                  la[r] = (i > j) ? -Bi * t[r] * ea : 0.f; aa[r] = (i >= j) ? 0.125f * u[r] * ea : 0.f;
                  if (cb == b) { const float eb = __expf(fminf(Gj[r] - Gi, 0.f)); mc[r] = -la[r]; nc[r] = (j > i) ? Bj[r] * t[r] * eb : 0.f; } }
              LA[b][cb] = cvt4(la); AAr[b * (b + 1) / 2 + cb] = cvt4(aa);
              if (cb == b) {
                  const s16x4 m1 = cvt4(mc), n1 = cvt4(nc);
                  const s16x4 m2 = cvt4(mfma16(n1, m1, Z)), n2 = cvt4(mfma16(m1, n1, Z));
                  const s16x4 m4 = cvt4(mfma16(n2, m2, Z)), n4 = cvt4(mfma16(m2, n2, Z));
                  const s16x4 n8 = cvt4(mfma16(m4, n4, Z));
                  f32x4 P;
#pragma unroll
                  for (int r = 0; r < 4; ++r) P[r] = ((4 * q + r == c) ? 1.f : 0.f) - mc[r];
                  P = mfma16(n2, cvt4(P), P); P = mfma16(n4, cvt4(P), P); P = mfma16(n8, cvt4(P), P);
                  dA[b] = cvt4(P); }
              __builtin_amdgcn_sched_barrier(0);
          }
      }
      s16x4 IB;
#pragma unroll
      for (int j = 0; j < 4; ++j) IB[j] = (4 * q + j == c) ? (short)0x3F80 : (short)0;
#pragma unroll
      for (int ks = 0; ks < 2; ++ks) {
          s16x4 wlo[4], whi[4];
#pragma unroll
          for (int hf = 0; hf < 2; ++hf) {
              s16x8 selh;
#pragma unroll
              for (int j = 0; j < 8; ++j) selh[j] = (8 * q + j == 16 * hf + c) ? (short)0x3F80 : (short)0;
              s16x4 xb[4];
#pragma unroll
              for (int b = 0; b < 4; ++b) { f32x4 acc = mfma32(kf[b][ks], selh, Z) * *(const LAS f32x4*)(BEs + 16 * b + 4 * q);
#pragma unroll
                  for (int cb = 0; cb < b; ++cb) acc = mfma16(LA[b][cb], xb[cb], acc);
                  xb[b] = cvt4(mfma16(dA[b], cvt4(acc), Z)); }
#pragma unroll
              for (int b = 0; b < 4; ++b) { const s16x4 w = cvt4(-mfma16(xb[b], IB, Z)); if (hf == 0) wlo[b] = w; else whi[b] = w; }
              s16x4 ub[4];
#pragma unroll
              for (int b = 0; b < 4; ++b) { f32x4 acc = mfma32(vf[b][ks], selh, Z) * *(const LAS f32x4*)(Bs + 16 * b + 4 * q);
#pragma unroll
                  for (int cb = 0; cb < b; ++cb) acc = mfma16(LA[b][cb], ub[cb], acc);
                  ub[b] = cvt4(mfma16(dA[b], cvt4(acc), Z)); }
              slu[((2 * ks + hf) * 2 + 0) * 64] = __builtin_bit_cast(v4u, cat(ub[0], ub[1]));
              slu[((2 * ks + hf) * 2 + 1) * 64] = __builtin_bit_cast(v4u, cat(ub[2], ub[3]));
              __builtin_amdgcn_sched_barrier(0);
          }
#pragma unroll
          for (int b = 0; b < 4; ++b) slw[(b * 2 + ks) * 64] = __builtin_bit_cast(v4u, cat(wlo[b], whi[b]));
      }
#undef MU_ROWC
    }
    s16x8 qa[4][2];
    __syncthreads();
    { const int dir = wave >> 2, g = wave & 3;
      f32x4 S[4] = {Z, Z, Z, Z};
      s16x8 kfn[4][2];
#define MU_KLOAD(n_) do { const int t0_ = dir == 0 ? start + (n_) * 64 : start + SEQ - 1 - (n_) * 64; _Pragma("unroll") for (int b_ = 0; b_ < 4; ++b_) { \
          const bf16_t* rp_ = cv + (size_t)(t0_ + (dir == 0 ? 1 : -1) * (16 * b_ + c)) * 1536 + 512 + 8 * q; kfn[b_][0] = *(const s16x8*)rp_; kfn[b_][1] = *(const s16x8*)(rp_ + 32); } } while (0)
      MU_KLOAD(0);
#pragma unroll
      for (int n = 0; n < 4; ++n) {
          const int slot = dir * 4 + n;
          if (n == 2) { const int dC = wave >> 2, nC = wave & 3, sgC = dC == 0 ? 1 : -1, t0C = dC == 0 ? start + nC * 64 : start + SEQ - 1 - nC * 64;
#pragma unroll
              for (int tb = 0; tb < 4; ++tb) { const bf16_t* rp = cv + (size_t)(t0C + sgC * (16 * tb + c)) * 1536 + 4 * q;
                  qa[tb][0] = cat(*(const s16x4*)rp, *(const s16x4*)(rp + 16)); qa[tb][1] = cat(*(const s16x4*)(rp + 32), *(const s16x4*)(rp + 48)); } }
          LAS v4u* slw = (LAS v4u*)(lds + slot * MU_SLOT) + lane; LAS v4u* slu = slw + 512;
          LAS float* gl = (LAS float*)(lds + MU_GATE) + slot * GL_FLOATS;
          const int sg = dir == 0 ? 1 : -1, t0 = dir == 0 ? start + n * 64 : start + SEQ - 1 - n * 64;
          s16x8 WAp[4][2], kf[4][2];
#pragma unroll
          for (int b = 0; b < 4; ++b) { kf[b][0] = kfn[b][0]; kf[b][1] = kfn[b][1]; }
          if (n < 3) MU_KLOAD(n + 1);
          (void)sg; (void)t0;
#pragma unroll
          for (int i = 0; i < 8; ++i) WAp[i >> 1][i & 1] = __builtin_bit_cast(s16x8, slw[i * 64]);
          const v4u u0 = slu[(g * 2) * 64], u1 = slu[(g * 2 + 1) * 64];
          const float dl = gl[128 + 63];
          __syncthreads();
          const s16x8 sb0 = cat(cvt4(S[0]), cvt4(S[1])), sb1 = cat(cvt4(S[2]), cvt4(S[3]));
          slu[(g * 2) * 64] = __builtin_bit_cast(v4u, sb0); slu[(g * 2 + 1) * 64] = __builtin_bit_cast(v4u, sb1);
          s16x4 vn[4], vs[4];
#pragma unroll
          for (int tb = 0; tb < 4; ++tb) { const v4u ur = (tb >> 1) ? u1 : u0; const unsigned w0 = (tb & 1) ? ur.z : ur.x, w1 = (tb & 1) ? ur.w : ur.y;
              f32x4 acc = {__uint_as_float(w0 << 16), __uint_as_float(w0 & 0xffff0000u), __uint_as_float(w1 << 16), __uint_as_float(w1 & 0xffff0000u)};
              acc = mfma32(WAp[tb][0], sb0, acc); acc = mfma32(WAp[tb][1], sb1, acc);
              vn[tb] = cvt4(acc); vs[tb] = cvt4(acc * *(const LAS f32x4*)(gl + 256 + 16 * tb + 4 * q)); }
          slw[(g * 2) * 64] = __builtin_bit_cast(v4u, cat(vn[0], vn[1])); slw[(g * 2 + 1) * 64] = __builtin_bit_cast(v4u, cat(vn[2], vn[3]));
          const s16x8 vs01 = cat(vs[0], vs[1]), vs23 = cat(vs[2], vs[3]);
#pragma unroll
          for (int db = 0; db < 4; ++db) { s16x8 sl;
#pragma unroll
              for (int j = 0; j < 8; ++j) sl[j] = (8 * q + j == 16 * (db & 1) + c) ? (short)0x3F80 : (short)0;
              const s16x8 k01 = cat(cvt4(mfma32(kf[0][db >> 1], sl, Z)), cvt4(mfma32(kf[1][db >> 1], sl, Z))), k23 = cat(cvt4(mfma32(kf[2][db >> 1], sl, Z)), cvt4(mfma32(kf[3][db >> 1], sl, Z)));
              f32x4 acc = S[db] * dl; acc = mfma32(k01, vs01, acc); acc = mfma32(k23, vs23, acc); S[db] = acc; }
      }
#undef MU_KLOAD
      float* so = p.out + (dir == 0 ? O_SF : O_SB) + ((size_t)s * 8 + h) * 4096;
#pragma unroll
      for (int db = 0; db < 4; ++db)
#pragma unroll
          for (int r = 0; r < 4; ++r) so[(16 * db + 4 * q + r) * 64 + 16 * g + c] = S[db][r];
    }
    __syncthreads();
    f32x4 O[4][4];
    uint2 zq[4][4];
    { const bf16_t* proj = (const bf16_t*)(p.ws + WS_PROJ);
#pragma unroll
      for (int tb = 0; tb < 4; ++tb)
#pragma unroll
          for (int g = 0; g < 4; ++g) zq[tb][g] = *(const uint2*)(proj + (size_t)(start + 64 * (wave & 3) + 16 * tb + c) * IN_W + C_DZ + h * 64 + 16 * g + 4 * q); }
    float gnv[4];
#pragma unroll
    for (int g = 0; g < 4; ++g) gnv[g] = p.dn_norm_g[16 * g + c];
    { const int dir = wave >> 2, n = wave & 3;
      LAS v4u* slw = (LAS v4u*)(lds + wave * MU_SLOT) + lane; LAS v4u* slu = slw + 512;
      LAS float* gl = (LAS float*)(lds + MU_GATE) + wave * GL_FLOATS;
      const int sg = dir == 0 ? 1 : -1, t0 = dir == 0 ? start + n * 64 : start + SEQ - 1 - n * 64;
      f32x4 eg[4]; (void)sg; (void)t0;
#pragma unroll
      for (int tb = 0; tb < 4; ++tb) eg[tb] = *(const LAS f32x4*)(gl + 128 + 16 * tb + 4 * q) * 0.125f;
#pragma unroll
      for (int g = 0; g < 4; ++g) {
          const s16x8 sb0 = __builtin_bit_cast(s16x8, slu[(g * 2) * 64]), sb1 = __builtin_bit_cast(s16x8, slu[(g * 2 + 1) * 64]);
          const s16x8 v01 = __builtin_bit_cast(s16x8, slw[(g * 2) * 64]), v23 = __builtin_bit_cast(s16x8, slw[(g * 2 + 1) * 64]);
          const s16x4 vn[4] = {__builtin_shufflevector(v01, v01, 0, 1, 2, 3), __builtin_shufflevector(v01, v01, 4, 5, 6, 7), __builtin_shufflevector(v23, v23, 0, 1, 2, 3), __builtin_shufflevector(v23, v23, 4, 5, 6, 7)};
#pragma unroll
          for (int tb = 0; tb < 4; ++tb) { f32x4 acc = mfma32(qa[tb][0], sb0, Z); acc = mfma32(qa[tb][1], sb1, acc);
              acc = acc * eg[tb];
#pragma unroll
              for (int tc = 0; tc <= tb; ++tc) acc = mfma16(AAr[tb * (tb + 1) / 2 + tc], vn[tc], acc);
              O[g][tb] = acc; }
      }
    }
    __syncthreads();
    if (wave >= 4) { LAS f32x4* ob = (LAS f32x4*)(lds + (wave & 3) * MU_SLOT) + lane;
#pragma unroll
        for (int g = 0; g < 4; ++g)
#pragma unroll
            for (int tb = 0; tb < 4; ++tb) ob[(g * 4 + tb) * 64] = O[g][tb]; }
    __syncthreads();
    if (wave < 4) { const int j = wave;
        const LAS float* ob = (const LAS float*)(lds + (3 - j) * MU_SLOT);
#pragma unroll
        for (int g = 0; g < 4; ++g)
#pragma unroll
            for (int tb = 0; tb < 4; ++tb)
#pragma unroll
                for (int r = 0; r < 4; ++r) O[g][tb][r] += ob[((g * 4 + (3 - tb)) * 64 + (lane ^ 48)) * 4 + (3 - r)];
        s16x4 IB;
#pragma unroll
        for (int jx = 0; jx < 4; ++jx) IB[jx] = (4 * q + jx == c) ? (short)0x3F80 : (short)0;
        bf16_t* odp = (bf16_t*)(p.ws + WS_OD);
#pragma unroll
        for (int tb = 0; tb < 4; ++tb) {
            f32x4 ss = Z;
#pragma unroll
            for (int g = 0; g < 4; ++g) ss += O[g][tb] * O[g][tb];
#pragma unroll
            for (int r = 0; r < 4; ++r) { const float v = red16(ss[r]); ss[r] = __builtin_amdgcn_rsqf(v * (1.f / 64.f) + EPS); }
            const int tok = start + 64 * j + 16 * tb + c;
#pragma unroll
            for (int g = 0; g < 4; ++g) { const float gn = gnv[g];
                const f32x4 y = mfma16(cvt4(O[g][tb] * ss * gn), IB, Z);
                const uint2 zz = zq[tb][g];
                const float z0 = __uint_as_float(zz.x << 16), z1 = __uint_as_float(zz.x & 0xffff0000u), z2 = __uint_as_float(zz.y << 16), z3 = __uint_as_float(zz.y & 0xffff0000u);
                uint2 o; o.x = dn::cvtpk(y[0] * z0 * pg8::sigm_(z0), y[1] * z1 * pg8::sigm_(z1)); o.y = dn::cvtpk(y[2] * z2 * pg8::sigm_(z2), y[3] * z3 * pg8::sigm_(z3));
                *(uint2*)(odp + (size_t)tok * 512 + h * 64 + 16 * g + 4 * q) = o; }
        }
    }
    __syncthreads();
}
}

namespace at {
using dn::s16x4; using dn::s16x8; using dn::cvt4; using dn::mfma16;
constexpr int P = 72, OFF_K = 0, OFF_V = 9216;
__device__ __forceinline__ void attn_unit(const Prm& p, LAS unsigned char* lds, int s, int kvh, int qb, int tid) {
    const int wave = __builtin_amdgcn_readfirstlane(tid >> 6), lane = tid & 63, q4 = lane >> 4, c = lane & 15;
    int start, len; seqinfo(s, start, len);
    const int npast = s >= BATCH ? PAST : 0, ntile = (npast + len) / 64;
    const bf16_t* QB = (const bf16_t*)(p.ws + WS_QK); const bf16_t* KB = QB + (size_t)T * 512;
    const bf16_t* proj = (const bf16_t*)(p.ws + WS_PROJ);
    bf16_t* OA = (bf16_t*)(p.ws + WS_OA);
    constexpr int TILE = 18432;
    const int head = kvh * 4 + (wave >> 1), trow = start + qb * 32 + (wave & 1) * 16 + c;
    s16x8 qf[2];
#pragma unroll
    for (int ks = 0; ks < 2; ++ks) qf[ks] = *(const s16x8*)(QB + (size_t)trow * 512 + head * 64 + 32 * ks + 8 * q4);
    f32x4 o[4];
#pragma unroll
    for (int dt = 0; dt < 4; ++dt) o[dt] = (f32x4){0.f, 0.f, 0.f, 0.f};
    float m = -1e30f, l = 0.f;
    const int lkey = tid >> 3, part = tid & 7;
    v4u kreg, vreg;
#define AT_LOAD(kt) do { const int keyidx = (kt) * 64 + lkey; \
        if (keyidx < npast) { const size_t off = (((size_t)(s - BATCH) * PAST + keyidx) * 2 + kvh) * 64 + part * 8; \
            const f32x4 a = *(const f32x4*)(p.cache_k + off), b = *(const f32x4*)(p.cache_k + off + 4), cc = *(const f32x4*)(p.cache_v + off), d = *(const f32x4*)(p.cache_v + off + 4); \
            kreg.x = dn::cvtpk(a[0], a[1]); kreg.y = dn::cvtpk(a[2], a[3]); kreg.z = dn::cvtpk(b[0], b[1]); kreg.w = dn::cvtpk(b[2], b[3]); \
            vreg.x = dn::cvtpk(cc[0], cc[1]); vreg.y = dn::cvtpk(cc[2], cc[3]); vreg.z = dn::cvtpk(d[0], d[1]); vreg.w = dn::cvtpk(d[2], d[3]); } \
        else { const int tk = start + keyidx - npast; kreg = *(const v4u*)(KB + (size_t)tk * 128 + kvh * 64 + part * 8); vreg = *(const v4u*)(proj + (size_t)tk * IN_W + C_AV + kvh * 64 + part * 8); } } while (0)
#define AT_STORE(buf) do { LAS bf16_t* Kl_ = (LAS bf16_t*)(lds + (buf) * TILE); LAS bf16_t* Vt_ = Kl_ + 64 * P; \
        *(LAS v4u*)(Kl_ + lkey * P + part * 8) = kreg; const unsigned vw_[4] = {vreg.x, vreg.y, vreg.z, vreg.w}; const int ksw_ = lkey ^ (part << 3); \
        _Pragma("unroll") for (int j = 0; j < 4; ++j) { Vt_[(part * 8 + 2 * j) * P + ksw_] = (bf16_t)(vw_[j] & 0xffffu); Vt_[(part * 8 + 2 * j + 1) * P + ksw_] = (bf16_t)(vw_[j] >> 16); } } while (0)
    AT_LOAD(0); AT_STORE(0);
    if (ntile > 1) AT_LOAD(1);
    __syncthreads();
    for (int kt = 0; kt < ntile; ++kt) {
        if (kt + 1 < ntile) { AT_STORE((kt + 1) & 1); if (kt + 2 < ntile) AT_LOAD(kt + 2); }
        const LAS bf16_t* Kl = (const LAS bf16_t*)(lds + (kt & 1) * TILE); const LAS bf16_t* Vt = Kl + 64 * P;
        f32x4 sc[4];
#pragma unroll
        for (int k16 = 0; k16 < 4; ++k16) { f32x4 acc = {0.f, 0.f, 0.f, 0.f};
#pragma unroll
            for (int ks = 0; ks < 2; ++ks) { const s16x8 a = *(const LAS s16x8*)(Kl + (16 * k16 + c) * P + 32 * ks + 8 * q4); acc = __builtin_amdgcn_mfma_f32_16x16x32_bf16(a, qf[ks], acc, 0, 0, 0); }
            sc[k16] = acc; }
        float mx = sc[0][0];
#pragma unroll
        for (int k16 = 0; k16 < 4; ++k16)
#pragma unroll
            for (int r = 0; r < 4; ++r) mx = fmaxf(mx, sc[k16][r]);
        mx = fmaxf(mx, __shfl_xor(mx, 16)); mx = fmaxf(mx, __shfl_xor(mx, 32));
        const float mn = fmaxf(m, mx), alpha = __expf(m - mn); m = mn;
        float rs = 0.f; s16x4 pb[4];
#pragma unroll
        for (int k16 = 0; k16 < 4; ++k16) { f32x4 pv;
#pragma unroll
            for (int r = 0; r < 4; ++r) { pv[r] = __expf(sc[k16][r] - mn); rs += pv[r]; }
            pb[k16] = cvt4(pv); }
        rs += __shfl_xor(rs, 16); rs += __shfl_xor(rs, 32);
        l = l * alpha + rs;
#pragma unroll
        for (int dt = 0; dt < 4; ++dt) { o[dt] *= alpha; const int dsw = ((16 * dt + c) >> 3) << 3;
#pragma unroll
            for (int k16 = 0; k16 < 4; ++k16) { const s16x4 a = *(const LAS s16x4*)(Vt + (16 * dt + c) * P + ((16 * k16 + 4 * q4) ^ dsw)); o[dt] = mfma16(a, pb[k16], o[dt]); } }
        __syncthreads();
    }
#undef AT_LOAD
#undef AT_STORE
    const float il = 1.f / l;
#pragma unroll
    for (int dt = 0; dt < 4; ++dt) { uint2 u; u.x = dn::cvtpk(o[dt][0] * il, o[dt][1] * il); u.y = dn::cvtpk(o[dt][2] * il, o[dt][3] * il);
        *(uint2*)(OA + (size_t)trow * 512 + head * 64 + 16 * dt + 4 * q4) = u; }
}

constexpr int PV = SEQ + 8, OFF_VR = SEQ * P * 2;
static_assert(SEQ == 256, "attn_unit_res is written for 256-key prompt sequences");
__device__ __forceinline__ void attn_unit_res(const Prm& p, LAS unsigned char* lds, int s, int kvh, int tid) {
    const int wave = __builtin_amdgcn_readfirstlane(tid >> 6), lane = tid & 63, q4 = lane >> 4, c = lane & 15;
    const int start = s * SEQ;
    const bf16_t* QB = (const bf16_t*)(p.ws + WS_QK); const bf16_t* KB = QB + (size_t)T * 512;
    const bf16_t* proj = (const bf16_t*)(p.ws + WS_PROJ);
    bf16_t* OA = (bf16_t*)(p.ws + WS_OA);
    LAS bf16_t* Kl = (LAS bf16_t*)(lds); LAS bf16_t* Vt = (LAS bf16_t*)(lds + OFF_VR);
    { const int part = tid & 7; v4u kr[4], vr[4];
#pragma unroll
      for (int r = 0; r < 4; ++r) { const int key = (tid >> 3) + 64 * r; const int tk = start + key;
          kr[r] = *(const v4u*)(KB + (size_t)tk * 128 + kvh * 64 + part * 8); vr[r] = *(const v4u*)(proj + (size_t)tk * IN_W + C_AV + kvh * 64 + part * 8); }
#pragma unroll
      for (int r = 0; r < 4; ++r) { const int key = (tid >> 3) + 64 * r;
          *(LAS v4u*)(Kl + key * P + part * 8) = kr[r];
          const unsigned vw[4] = {vr[r].x, vr[r].y, vr[r].z, vr[r].w};
#pragma unroll
          for (int j = 0; j < 4; ++j) { Vt[(part * 8 + 2 * j) * PV + key] = (bf16_t)(vw[j] & 0xffffu); Vt[(part * 8 + 2 * j + 1) * PV + key] = (bf16_t)(vw[j] >> 16); } } }
    s16x8 qn0, qn1;
    { const int head = kvh * 4 + (wave >> 4), trow = start + (wave & 15) * 16 + c;
      qn0 = *(const s16x8*)(QB + (size_t)trow * 512 + head * 64 + 8 * q4); qn1 = *(const s16x8*)(QB + (size_t)trow * 512 + head * 64 + 32 + 8 * q4); }
    __syncthreads();
    for (int task = wave; task < 64; task += 8) {
        const int head = kvh * 4 + (task >> 4), trow = start + (task & 15) * 16 + c;
        const s16x8 qf0 = qn0, qf1 = qn1;
        if (task + 8 < 64) { const int h2 = kvh * 4 + ((task + 8) >> 4), t2 = start + ((task + 8) & 15) * 16 + c;
            qn0 = *(const s16x8*)(QB + (size_t)t2 * 512 + h2 * 64 + 8 * q4); qn1 = *(const s16x8*)(QB + (size_t)t2 * 512 + h2 * 64 + 32 + 8 * q4); }
        f32x4 sc[16];
#pragma unroll
        for (int k16 = 0; k16 < 16; ++k16) { f32x4 acc = {0.f, 0.f, 0.f, 0.f};
            acc = __builtin_amdgcn_mfma_f32_16x16x32_bf16(*(const LAS s16x8*)(Kl + (16 * k16 + c) * P + 8 * q4), qf0, acc, 0, 0, 0);
            acc = __builtin_amdgcn_mfma_f32_16x16x32_bf16(*(const LAS s16x8*)(Kl + (16 * k16 + c) * P + 32 + 8 * q4), qf1, acc, 0, 0, 0);
            sc[k16] = acc;
            if ((k16 & 3) == 3) __builtin_amdgcn_sched_barrier(0); }
        float mx = sc[0][0];
#pragma unroll
        for (int k16 = 0; k16 < 16; ++k16)
#pragma unroll
            for (int r = 0; r < 4; ++r) mx = fmaxf(mx, sc[k16][r]);
        mx = fmaxf(mx, __shfl_xor(mx, 16)); mx = fmaxf(mx, __shfl_xor(mx, 32));
        float rs = 0.f; s16x4 pb[16];
#pragma unroll
        for (int k16 = 0; k16 < 16; ++k16) { f32x4 pv;
#pragma unroll
            for (int r = 0; r < 4; ++r) { pv[r] = __expf(sc[k16][r] - mx); rs += pv[r]; }
            pb[k16] = cvt4(pv); }
        rs += __shfl_xor(rs, 16); rs += __shfl_xor(rs, 32);
        const float il = 1.f / rs;
#pragma unroll
        for (int dt = 0; dt < 4; ++dt) { f32x4 o = {0.f, 0.f, 0.f, 0.f};
#pragma unroll
            for (int k16 = 0; k16 < 16; ++k16) { o = mfma16(*(const LAS s16x4*)(Vt + (16 * dt + c) * PV + 16 * k16 + 4 * q4), pb[k16], o); if ((k16 & 7) == 7) __builtin_amdgcn_sched_barrier(0); }
            uint2 u; u.x = dn::cvtpk(o[0] * il, o[1] * il); u.y = dn::cvtpk(o[2] * il, o[3] * il);
            *(uint2*)(OA + (size_t)trow * 512 + head * 64 + 16 * dt + 4 * q4) = u; }
    }
    __syncthreads();
}
}

__device__ __forceinline__ void attn_queue_latent(const Prm& p, LAS unsigned char* lds, int tid, int ctr_word) {
    constexpr int N_LA = DEC_BATCH * 2 * (DEC_SEQ / 32);
    unsigned* ctr = (unsigned*)(p.ws + WS_BAR) + ctr_word;
    LAS unsigned* slot = (LAS unsigned*)(lds + LDS_CTRL + 16);
    __syncthreads();
    for (;;) {
        if (tid == 0) *slot = atomicAdd(ctr, 1u);
        __syncthreads();
        const int u = __builtin_amdgcn_readfirstlane((int)*slot);
        __syncthreads();
        if (u >= N_LA) break;
        constexpr int per = 2 * (DEC_SEQ / 32); at::attn_unit(p, lds, BATCH + u / per, (u % per) / (DEC_SEQ / 32), u % (DEC_SEQ / 32), tid);
    }
}
__device__ __forceinline__ void attn_queue_prompt(const Prm& p, LAS unsigned char* lds, int tid, int ctr_word) {
    constexpr int N_PA = BATCH * 2;
    unsigned* ctr = (unsigned*)(p.ws + WS_BAR) + ctr_word;
    LAS unsigned* slot = (LAS unsigned*)(lds + LDS_CTRL + 16);
    __syncthreads();
    for (;;) {
        if (tid == 0) *slot = atomicAdd(ctr, 1u);
        __syncthreads();
        const int u = __builtin_amdgcn_readfirstlane((int)*slot);
        __syncthreads();
        if (u >= N_PA) break;
        at::attn_unit_res(p, lds, u >> 1, u & 1, tid);
    }
}
__device__ __forceinline__ void publish_count(unsigned* cnt, int tid) {
    asm volatile("s_waitcnt vmcnt(0)" ::: "memory");
    __syncthreads();
    if (tid == 0) { __builtin_amdgcn_fence(__ATOMIC_RELEASE, "agent"); asm volatile("s_waitcnt vmcnt(0)" ::: "memory"); __hip_atomic_fetch_add(cnt, 1u, __ATOMIC_RELAXED, __HIP_MEMORY_SCOPE_AGENT); }
}
__device__ __forceinline__ void wait_count(unsigned* cnt, unsigned want, int tid) {
    if (tid == 0) { unsigned spins = 0;
        while (__hip_atomic_load(cnt, __ATOMIC_RELAXED, __HIP_MEMORY_SCOPE_AGENT) < want) { __builtin_amdgcn_s_sleep(8); if (++spins > (1u << 22)) break; }
        __builtin_amdgcn_fence(__ATOMIC_ACQUIRE, "agent"); asm volatile("s_waitcnt vmcnt(0)" ::: "memory"); }
    __syncthreads();
}
struct TwoStage {
    pg8::StaticOrder s;
    __device__ bool next(int i, pg8::Unit& u) const { if (!s.next(i >> 1, u)) return false; u.kind = i & 1; return true; }
    __device__ __forceinline__ void a_ready(const pg8::Unit&) const {}
    __device__ __forceinline__ void done(const pg8::Unit&) const {}
};
__device__ __forceinline__ void mix_phase(const Prm& p, LAS unsigned char* lds, int tid, int gw, int wave, int lane) {
    constexpr int N_LSH = DEC_BATCH * 8, N_PAWG = DEC_BATCH * 16 * (DEC_SEQ / 64) / 8;
    static_assert(dw::MU_LDS <= LDS_CTRL, "prompt_unit LDS");
    unsigned* cw = (unsigned*)(p.ws + WS_BAR);
    const int b = blockIdx.x;
    if (b >= (int)gridDim.x / 2) attn_queue_latent(p, lds, tid, 16);
    if (b >= N_LSH && b < N_LSH + N_PAWG) {
        const int t = (b - N_LSH) * 8 + wave;
        dw::pa_task(p, (LAS float*)lds + wave * dw::GL_FLOATS, BATCH * 16 + t / (DEC_SEQ / 64), t % (DEC_SEQ / 64), lane);
        publish_count(cw + 18, tid);
    }
    if (b < N_LSH) {
        wait_count(cw + 18, (unsigned)N_PAWG, tid);
        dw::pb1_task(p, (BATCH * 8 + b) * 2 + (wave >> 2), wave & 3, lane);
        publish_count(cw + 24 + b, tid);
    } else if (b < BATCH * 8) dw::prompt_unit(p, lds, b, tid);
    if (b >= (int)gridDim.x / 2 - N_LSH && b < (int)gridDim.x / 2) dw::prompt_unit(p, lds, b - ((int)gridDim.x / 2 - N_LSH), tid);
    if (!(b >= (int)gridDim.x / 2 - N_LSH && b < (int)gridDim.x / 2)) attn_queue_prompt(p, lds, tid, 20);
    { constexpr int NL4 = DEC_BATCH * 8 * (DEC_SEQ / 64) * 4;
      if (gw < NL4) { const int lsh = (gw >> 2) / (DEC_SEQ / 64);
          if (lane == 0) { unsigned spins = 0;
              while (__hip_atomic_load(cw + 24 + lsh, __ATOMIC_RELAXED, __HIP_MEMORY_SCOPE_AGENT) < 1u) { __builtin_amdgcn_s_sleep(8); if (++spins > (1u << 22)) break; } }
          __builtin_amdgcn_fence(__ATOMIC_ACQUIRE, "agent"); asm volatile("s_waitcnt vmcnt(0)" ::: "memory");
          dw::pc4_task(p, BATCH * 8 + lsh, (gw >> 2) % (DEC_SEQ / 64), gw & 3, lane); } }
}
__global__ void __launch_bounds__(NTHREADS, 2) fwd_kernel(Prm p) {
    extern __shared__ __attribute__((aligned(16))) unsigned char lds_raw[];
    LAS unsigned char* lds = (LAS unsigned char*)lds_raw;
    const int tid = threadIdx.x, lane = tid & 63, wave = __builtin_amdgcn_readfirstlane(tid >> 6);
    if (tid < 2) ((LAS unsigned*)(lds + LDS_CTRL))[tid] = 0u;
    __syncthreads();
    const XcdBarrier bar = xcd_barrier_post((unsigned*)(p.ws + WS_BAR), (volatile LAS unsigned*)(lds + LDS_CTRL));
#define GRID_SYNC() xcd_barrier(bar)
    const int G = gridDim.x, gw = blockIdx.x * NWAVES + wave, NGW = G * NWAVES;
    const long gtid = (long)blockIdx.x * NTHREADS + tid, gn = (long)G * NTHREADS;
    unsigned char* ws = p.ws;
    mod_gemv(p, lds, tid); p0_weights(p, (LAS float*)(lds + wave * 16384), gw, NGW, P0_I_EARLY, lane); GRID_SYNC();
    norm_rows(p, 0, gw, NGW, lane); GRID_SYNC();
    { pg8::Gemm g{(const bf16_t*)(ws + WS_H), (const bf16_t*)(ws + WS_WIN), T, N_MAIN, D, nullptr, nullptr}; pg8::StaticOrder S; S.init(T, N_MAIN, G, (int)blockIdx.x);
      pg8::EpiStore E{(bf16_t*)(ws + WS_PROJ), IN_W};
      pg8::gemm_phase<pg8::EpiStore, pg8::StaticOrder, true, true>(lds, g, S, E); }
    mini_gemm_gates(p, lds, tid);
    GRID_SYNC();
    qk_prep(p, gw, NGW, lane); conv_prep(p, gw, NGW, lane); GRID_SYNC();
    mix_phase(p, lds, tid, gw, wave, lane); GRID_SYNC();
    { constexpr int MERGE_TILES = (T / 256) * (D / 256);
      if ((int)blockIdx.x >= MERGE_TILES) p0_weights(p, (LAS float*)(lds + wave * 16384), P0_I_EARLY + ((int)blockIdx.x - MERGE_TILES) * NWAVES + wave, (G - MERGE_TILES) * NWAVES, P0_I_MID, lane); }
    { pg8::Gemm g{(const bf16_t*)(ws + WS_OD), (const bf16_t*)(ws + WS_WPB), T, D, 512, (const bf16_t*)(ws + WS_OA), (const bf16_t*)(ws + WS_WPA)};
      TwoStage S; S.s.init(T, D, G, (int)blockIdx.x);
      pg8::EpiMerge E{(bf16_t*)(ws + WS_MG), D, (const bf16_t*)(ws + WS_PROJ) + C_GA, (const bf16_t*)(ws + WS_PROJ) + C_GB, IN_W};
      pg8::gemm_phase<pg8::EpiMerge, TwoStage, true, true>(lds, g, S, E); }
    GRID_SYNC();
    { constexpr int WO_TILES = (T / 256) * (D / 256);
      if ((int)blockIdx.x >= WO_TILES) { p0_weights(p, (LAS float*)(lds + wave * 16384), P0_I_MID + ((int)blockIdx.x - WO_TILES) * NWAVES + wave, (G - WO_TILES) * NWAVES, P0_I_LATE, lane);
          const int nw = (G - WO_TILES) * NWAVES, w0 = ((int)blockIdx.x - WO_TILES) * NWAVES + wave; float dummy = 0.f;
          for (int t = 2 * w0; t < T; t += 2 * nw) { f32x4 v[2][4];
#pragma unroll
              for (int a = 0; a < 2; ++a) { const float* x = xrow(p, t + a < T ? t + a : T - 1);
#pragma unroll
                  for (int j = 0; j < 4; ++j) v[a][j] = *(const f32x4*)(x + 4 * lane + 256 * j); }
#pragma unroll
              for (int a = 0; a < 2; ++a)
#pragma unroll
                  for (int j = 0; j < 4; ++j) dummy += v[a][j][0]; }
          if (dummy == 1.2345e-30f) ((float*)(ws + WS_TMP))[lane] = dummy; } }
    { pg8::Gemm g{(const bf16_t*)(ws + WS_MG), (const bf16_t*)(ws + WS_WO), T, D, D, nullptr, nullptr}; pg8::StaticOrder S; S.init(T, D, G, (int)blockIdx.x);
      pg8::EpiResidA E{p.x_prompt, p.x_sample, (bf16_t*)(ws + WS_X1), (const float*)(ws + WS_MOD), 2 * D};
      pg8::gemm_phase<pg8::EpiResidA, pg8::StaticOrder, true, true>(lds, g, S, E); }
    GRID_SYNC();
    norm_rows(p, 1, gw, NGW, lane); GRID_SYNC();
    { pg8::Gemm g{(const bf16_t*)(ws + WS_H), (const bf16_t*)(ws + WS_WGU), T, 2 * FF, D, nullptr, nullptr}; pg8::StaticOrder S; S.init(T, 2 * FF, G, (int)blockIdx.x);
      pg8::EpiSwiglu E{(bf16_t*)(ws + WS_PROJ)};
      pg8::gemm_phase<pg8::EpiSwiglu, pg8::StaticOrder, true, true>(lds, g, S, E);
      constexpr int UP_FULL = (T / 256) * (2 * FF / 256) % 256;
      if ((int)blockIdx.x >= UP_FULL) p0_weights(p, (LAS float*)(lds + wave * 16384), P0_I_LATE + ((int)blockIdx.x - UP_FULL) * NWAVES + wave, (G - UP_FULL) * NWAVES, P0_NITEMS, lane); }
    GRID_SYNC();
    { pg8::Gemm g{(const bf16_t*)(ws + WS_PROJ), (const bf16_t*)(ws + WS_WDN), T, D, FF, nullptr, nullptr}; pg8::StaticOrder S; S.init(T, D, G, (int)blockIdx.x);
      pg8::EpiResidB E{(const bf16_t*)(ws + WS_X1), p.out + O_Y, (const float*)(ws + WS_MOD), 5 * D};
      pg8::gemm_phase<pg8::EpiResidB, pg8::StaticOrder, true, true>(lds, g, S, E); }
}

extern "C" void kernel_launch(void* const* d_in, const int* in_sizes, int n_in, void* d_out, int out_size, void* d_ws, size_t ws_size,
                              hipStream_t stream) {
    static int grid_blocks = 0;
    if (!grid_blocks) {
        int dev = 0, cus = 0, per_cu = 0;
        (void)hipGetDevice(&dev);
        (void)hipDeviceGetAttribute(&cus, hipDeviceAttributeMultiprocessorCount, dev);
        (void)hipFuncSetAttribute((const void*)fwd_kernel, hipFuncAttributeMaxDynamicSharedMemorySize, LDS_BYTES);
        (void)hipOccupancyMaxActiveBlocksPerMultiprocessor(&per_cu, (const void*)fwd_kernel, NTHREADS, LDS_BYTES);
        if (per_cu < 1) { fprintf(stderr, "kernel_launch: occupancy query says %d blocks per CU\n", per_cu); per_cu = 1; }
        grid_blocks = cus;
        if (cus < BATCH * 8) fprintf(stderr, "kernel_launch: this build needs >= %d CUs (one workgroup per prompt (seq, head) unit); device has %d\n", BATCH * 8, cus);
        if (ws_size < WS_END || n_in != 25 || (size_t)out_size != O_END)
            fprintf(stderr, "kernel_launch: unexpected sizes ws %zu (need %zu) n_in %d out %d (expect %zu)\n", ws_size, (size_t)WS_END, n_in, out_size, (size_t)O_END);
    }
    Prm p{};
    const float** pp = (const float**)&p;
    for (int i = 0; i < 25; ++i) pp[i] = (const float*)d_in[i];
    p.out = (float*)d_out; p.ws = (unsigned char*)d_ws;
    (void)hipMemsetAsync((char*)d_ws + WS_BAR, 0, WS_ZERO_BYTES, stream);
    void* args[] = {&p};
    hipError_t e = hipLaunchCooperativeKernel((const void*)fwd_kernel, dim3(grid_blocks), dim3(NTHREADS), args, LDS_BYTES, stream);
    if (e != hipSuccess) fprintf(stderr, "cooperative launch failed: %s (grid %d)\n", hipGetErrorString(e), grid_blocks);
}
#endif
```

```cpp
#ifndef HOST_EMU
#include <hip/hip_runtime.h>
#include <hip/hip_cooperative_groups.h>
namespace cg = cooperative_groups;
#define DEVFN __device__ __forceinline__
#else
#include <cmath>
#include <cstring>
#include <cstdint>
#include <cstddef>
#define DEVFN static inline
#endif
#include <cstdio>

#ifdef SMALL_DIMS
constexpr int BATCH = 3, SEQ = 128, DEC_BATCH = 2, DEC_SEQ = 256, PAST = 128;
#else
constexpr int BATCH = 32, SEQ = 256, DEC_BATCH = 2, DEC_SEQ = 1024, PAST = 512;
#endif
constexpr int D = 1024, HD = 64, NQH = 8, NKVH = 2, DNH = 8, FF = 2816, GRID_W = 64;
constexpr int TP = BATCH * SEQ, TL = DEC_BATCH * DEC_SEQ, T = TP + TL, NMOD = 1 + DEC_BATCH, NSEQ = BATCH + DEC_BATCH;
constexpr int IN_W = 4896;
constexpr int C_AQ = 0, C_AK = 512, C_AV = 640, C_DQ = 768, C_DZ = 2304, C_GA = 2816, C_GB = 3840, C_BETA = 4864, C_ALPHA = 4880, N_MAIN = 4864;
static_assert(C_DZ % 256 == 0 && C_GA % 256 == 0 && C_GA - C_DZ == 512 && N_MAIN - C_GA == 2048, "the projection epilogue treats whole 256-column tiles: z tiles, then the (ga | gb) interleaved gate tiles");
#ifndef HOST_EMU
__host__ __device__
#endif
inline int wsrc_col(int c) { return c < 2816 ? c : (c < N_MAIN ? c + 32 : c - N_MAIN + 2816); }
constexpr float EPS = 1e-6f;
constexpr size_t O_Y = 0, O_K = (size_t)T * D, O_V = O_K + (size_t)TP * 128, O_SF = O_V + (size_t)TP * 128, O_SB = O_SF + (size_t)BATCH * 8 * 64 * 64,
                 O_END = O_SB + (size_t)BATCH * 8 * 64 * 64;

typedef unsigned short bf16_t;
DEVFN bf16_t f2bf(float f) { unsigned u; memcpy(&u, &f, 4); u = (u + 0x7fffu + ((u >> 16) & 1u)) >> 16; return (bf16_t)u; }
DEVFN float bf2f(bf16_t h) { unsigned u = ((unsigned)h) << 16; float f; memcpy(&f, &u, 4); return f; }
DEVFN float ldf(const float* p, size_t i) { return p[i]; }
DEVFN float ldf(const bf16_t* p, size_t i) { return bf2f(p[i]); }
DEVFN void stf(float* p, size_t i, float v) { p[i] = v; }
DEVFN void stf(bf16_t* p, size_t i, float v) { p[i] = f2bf(v); }
DEVFN float siluf(float x) { return x / (1.f + expf(-x)); }
DEVFN float sigmf(float x) { return 1.f / (1.f + expf(-x)); }
DEVFN float softplusf(float x) { return x > 20.f ? x : log1pf(expf(x)); }
#ifndef HOST_EMU
DEVFN float fsin(float x) { return __sinf(x); }
DEVFN float fcos(float x) { return __cosf(x); }
#else
DEVFN float fsin(float x) { return sinf(x); }
DEVFN float fcos(float x) { return cosf(x); }
#endif

typedef bf16_t proj_t;
typedef bf16_t act_t;
typedef bf16_t conv_t;
typedef bf16_t h_t;
typedef bf16_t o_t;
typedef bf16_t qk_t;
constexpr size_t al256(size_t x) { return (x + 255) & ~(size_t)255; }
constexpr size_t WS_BAR = 0;
constexpr size_t WS_MOD = 16384;
constexpr size_t WS_ZERO_BYTES = WS_MOD + (size_t)NMOD * 6 * D * 4;
constexpr size_t WS_WIN = al256(WS_MOD + (size_t)NMOD * 6 * D * 4);
constexpr size_t WS_WPA = al256(WS_WIN + (size_t)IN_W * D * 2);
constexpr size_t WS_WPB = al256(WS_WPA + (size_t)D * 512 * 2);
constexpr size_t WS_WO = al256(WS_WPB + (size_t)D * 512 * 2);
constexpr size_t WS_WGU = al256(WS_WO + (size_t)D * D * 2);
constexpr size_t WS_WDN = al256(WS_WGU + (size_t)2 * FF * D * 2);
constexpr size_t WS_H = al256(WS_WDN + (size_t)D * FF * 2);
static_assert((size_t)T * D * sizeof(h_t) == (size_t)T * 512 * 4, "odir fwd overlay");
constexpr size_t WS_QK = al256(WS_H + (size_t)T * D * sizeof(h_t));
constexpr size_t WS_OD1 = al256(WS_QK + (size_t)T * 640 * sizeof(qk_t));
constexpr size_t WS_QK_END = al256(WS_OD1 + (size_t)T * 512 * 4);
constexpr size_t WS_PROJ = WS_QK_END;
constexpr size_t WS_OA = al256(WS_PROJ + (size_t)T * IN_W * sizeof(proj_t));
constexpr size_t WS_OD = al256(WS_OA + (size_t)T * 512 * sizeof(o_t));
constexpr size_t WS_CONV = al256(WS_OD + (size_t)T * 512 * sizeof(o_t));
constexpr size_t WS_MG = WS_CONV, WS_TMP = al256(WS_MG + (size_t)T * D * sizeof(o_t));
constexpr size_t WS_X1 = WS_TMP;
constexpr size_t WS_CONV_END = al256(WS_TMP + (size_t)T * D * sizeof(o_t));
static_assert(WS_CONV_END - WS_CONV >= (size_t)T * 1536 * sizeof(conv_t), "conv region");
constexpr size_t WS_GB = WS_CONV_END;
constexpr int NCHUNK = BATCH * 16 * (SEQ / 64) + DEC_BATCH * 16 * (DEC_SEQ / 64);
constexpr size_t WS_SLW = WS_H;
constexpr size_t WS_SLU = WS_OD1;
static_assert((size_t)NCHUNK * 8192 <= (size_t)T * D * sizeof(h_t) && (size_t)NCHUNK * 8192 <= (size_t)T * 512 * 4, "slab overlays");
constexpr size_t SLA_BYTES = 10 * 512 + 512;
constexpr size_t WS_SLA = al256(WS_GB + (size_t)T * 32 * 4 + 256);
constexpr int NCHUNK_LAT = DEC_BATCH * 16 * (DEC_SEQ / 64), CHUNK_LAT0 = BATCH * 16 * (SEQ / 64);
constexpr size_t WS_SLV = al256(WS_SLA + (size_t)NCHUNK_LAT * SLA_BYTES);
constexpr size_t WS_END = al256(WS_SLV + (size_t)NCHUNK_LAT * 8192);

struct Prm {
    const float *x_prompt, *x_sample, *cache_k, *cache_v, *state_fwd, *state_bwd, *c, *c_ctx, *w_ada, *b_ada, *norm1_g, *w_in, *q_norm_g, *k_norm_g,
        *conv_w, *a_log, *dt_bias, *dn_norm_g, *w_pa, *w_pb, *w_o, *norm2_g, *w_gate, *w_up, *w_down;
    float* out; unsigned char* ws;
};
DEVFN const float* xrow(const Prm& p, int t) { return t < TP ? p.x_prompt + (size_t)t * D : p.x_sample + (size_t)(t - TP) * D; }
DEVFN int modidx(int t) { return t < TP ? 0 : 1 + (t - TP) / DEC_SEQ; }
DEVFN void seqinfo(int s, int& start, int& len) { if (s < BATCH) { start = s * SEQ; len = SEQ; } else { start = TP + (s - BATCH) * DEC_SEQ; len = DEC_SEQ; } }
DEVFN void tokinfo(int t, int& s, int& pos) { if (t < TP) { s = t / SEQ; pos = t % SEQ; } else { s = BATCH + (t - TP) / DEC_SEQ; pos = (t - TP) % DEC_SEQ; } }

DEVFN void n0_mod(const Prm& p, long gtid, long gn) {
    float* mod = (float*)(p.ws + WS_MOD);
    for (long i = gtid; i < (long)NMOD * 6 * D; i += gn) {
        const int m = (int)(i / (6 * D)), j = (int)(i % (6 * D));
        const float* cond = m == 0 ? p.c_ctx : p.c + (size_t)(m - 1) * D;
        float s = 0.f;
        for (int k = 0; k < D; ++k) s += siluf(cond[k]) * p.w_ada[(size_t)k * 6 * D + j];
        mod[i] = s + p.b_ada[j];
    }
}
DEVFN void n_norm(const Prm& p, int which, long gtid, long gn) {
    const float* mod = (const float*)(p.ws + WS_MOD);
    h_t* h = (h_t*)(p.ws + WS_H);
    for (long t = gtid; t < T; t += gn) {
        const float* x = which == 0 ? xrow(p, (int)t) : p.out + O_Y + (size_t)t * D;
        const float* g = which == 0 ? p.norm1_g : p.norm2_g;
        const float* sh = mod + (size_t)modidx((int)t) * 6 * D + (which == 0 ? 0 : 3 * D);
        const float* sc = sh + D;
        float ss = 0.f;
        for (int k = 0; k < D; ++k) ss += x[k] * x[k];
        const float rstd = 1.f / sqrtf(ss / D + EPS);
        for (int k = 0; k < D; ++k) stf(h, (size_t)t * D + k, x[k] * rstd * g[k] * (1.f + sc[k]) + sh[k]);
    }
}
template <typename TA>
DEVFN void gemm4x4(const TA* A, size_t lda, const float* B, size_t ldb, int K, int r0, int c0, float (&acc)[4][4]) {
#pragma unroll
    for (int i = 0; i < 4; ++i)
#pragma unroll
        for (int j = 0; j < 4; ++j) acc[i][j] = 0.f;
    for (int k = 0; k < K; ++k) {
        float a[4], b[4];
#pragma unroll
        for (int i = 0; i < 4; ++i) a[i] = ldf(A, (size_t)(r0 + i) * lda + k);
#pragma unroll
        for (int j = 0; j < 4; ++j) b[j] = B[(size_t)k * ldb + c0 + j];
#pragma unroll
        for (int i = 0; i < 4; ++i)
#pragma unroll
            for (int j = 0; j < 4; ++j) acc[i][j] += a[i] * b[j];
    }
}
DEVFN void n2_proj(const Prm& p, long gtid, long gn) {
    const h_t* h = (const h_t*)(p.ws + WS_H);
    proj_t* proj = (proj_t*)(p.ws + WS_PROJ);
    constexpr int NC = IN_W / 4;
    for (long i = gtid; i < (long)(T / 4) * NC; i += gn) {
        const int r0 = (int)(i / NC) * 4, c0 = (int)(i % NC) * 4;
        float acc[4][4];
        gemm4x4(h, D, p.w_in + (wsrc_col(c0) - c0), IN_W, D, r0, c0, acc);
#pragma unroll
        for (int a = 0; a < 4; ++a)
#pragma unroll
            for (int b = 0; b < 4; ++b) stf(proj, (size_t)(r0 + a) * IN_W + c0 + b, acc[a][b]);
    }
}
DEVFN void n3_qk(const Prm& p, long gtid, long gn) {
    const proj_t* proj = (const proj_t*)(p.ws + WS_PROJ);
    qk_t* qn = (qk_t*)(p.ws + WS_QK);
    qk_t* kn = qn + (size_t)T * 512;
    for (long i = gtid; i < (long)T * 12; i += gn) {
        const int t = (int)(i / 12), hh = (int)(i % 12);
        int s, pos; tokinfo(t, s, pos);
        if (hh >= 10) {
            if (t < TP) { const int kvh = hh - 10;
                for (int d = 0; d < 64; ++d) p.out[O_V + ((size_t)t * 2 + kvh) * 64 + d] = ldf(proj, (size_t)t * IN_W + C_AV + kvh * 64 + d); }
            continue;
        }
        const bool isq = hh < 8;
        const int col = isq ? C_AQ + hh * 64 : C_AK + (hh - 8) * 64;
        const float* g = isq ? p.q_norm_g : p.k_norm_g;
        float v[64]; float ss = 0.f;
#pragma unroll
        for (int d = 0; d < 64; ++d) { v[d] = ldf(proj, (size_t)t * IN_W + col + d); ss += v[d] * v[d]; }
        const float rstd = 1.f / sqrtf(ss / 64.f + EPS);
#pragma unroll
        for (int d = 0; d < 64; ++d) v[d] = v[d] * rstd * g[d];
        if (!isq && t < TP) {
#pragma unroll
            for (int d = 0; d < 64; ++d) p.out[O_K + ((size_t)t * 2 + (hh - 8)) * 64 + d] = v[d];
        }
        if (t >= TP) {
            const float rowp = (float)(pos / GRID_W), colp = (float)(pos % GRID_W);
#pragma unroll
            for (int j = 0; j < 16; ++j) {
                const float inv = exp2f(-(float)j * (13.287712379549449f / 16.f));
                float a1 = rowp * inv, a2 = colp * inv;
                float c1 = fcos(a1), s1 = fsin(a1), c2 = fcos(a2), s2 = fsin(a2);
                float x1 = v[j], x2 = v[16 + j]; v[j] = x1 * c1 - x2 * s1; v[16 + j] = x2 * c1 + x1 * s1;
                x1 = v[32 + j]; x2 = v[48 + j]; v[32 + j] = x1 * c2 - x2 * s2; v[48 + j] = x2 * c2 + x1 * s2;
            }
        }
        qk_t* dst = isq ? qn + (size_t)t * 512 + hh * 64 : kn + (size_t)t * 128 + (hh - 8) * 64;
#pragma unroll
        for (int d = 0; d < 64; ++d) stf(dst, d, isq ? v[d] * 0.125f : v[d]);
    }
}
template <typename TK, typename TV>
DEVFN void attn_step(const float (&q)[64], float (&o)[64], float& m, float& l, const TK* kp, const TV* vp) {
    float sc = 0.f;
#pragma unroll
    for (int d = 0; d < 64; ++d) sc += q[d] * ldf(kp, d);
    const float mn = sc > m ? sc : m;
    const float alpha = expf(m - mn), pe = expf(sc - mn);
    l = l * alpha + pe;
#pragma unroll
    for (int d = 0; d < 64; ++d) o[d] = o[d] * alpha + pe * ldf(vp, d);
    m = mn;
}
DEVFN void n4_attn(const Prm& p, long gtid, long gn) {
    const proj_t* proj = (const proj_t*)(p.ws + WS_PROJ);
    const qk_t* qn = (const qk_t*)(p.ws + WS_QK);
    const qk_t* kn = qn + (size_t)T * 512;
    o_t* oa = (o_t*)(p.ws + WS_OA);
    for (long i = gtid; i < (long)T * 8; i += gn) {
        const int t = (int)(i / 8), hq = (int)(i % 8), kvh = hq / 4;
        int s, pos; tokinfo(t, s, pos);
        int start, len; seqinfo(s, start, len);
        float q[64], o[64];
#pragma unroll
        for (int d = 0; d < 64; ++d) { q[d] = ldf(qn, (size_t)t * 512 + hq * 64 + d); o[d] = 0.f; }
        float m = -1e30f, l = 0.f;
        if (t >= TP) { const int b = s - BATCH;
            for (int j = 0; j < PAST; ++j) attn_step(q, o, m, l, p.cache_k + (((size_t)b * PAST + j) * 2 + kvh) * 64, p.cache_v + (((size_t)b * PAST + j) * 2 + kvh) * 64); }
        for (int j = 0; j < len; ++j) { const int tk = start + j;
            attn_step(q, o, m, l, kn + (size_t)tk * 128 + kvh * 64, proj + (size_t)tk * IN_W + C_AV + kvh * 64); }
        const float il = 1.f / l;
#pragma unroll
        for (int d = 0; d < 64; ++d) stf(oa, (size_t)t * 512 + hq * 64 + d, o[d] * il);
    }
}
DEVFN void n5a_conv(const Prm& p, long gtid, long gn) {
    const proj_t* proj = (const proj_t*)(p.ws + WS_PROJ);
    conv_t* cv = (conv_t*)(p.ws + WS_CONV);
    for (long i = gtid; i < (long)T * 1536; i += gn) {
        const int t = (int)(i / 1536), c = (int)(i % 1536);
        int s, pos; tokinfo(t, s, pos);
        int start, len; seqinfo(s, start, len);
        float y = 0.f;
#pragma unroll
        for (int j = 0; j < 5; ++j) { const int pp = pos - 2 + j; if (pp >= 0 && pp < len) y += p.conv_w[j * 1536 + c] * ldf(proj, (size_t)(start + pp) * IN_W + C_DQ + c); }
        stf(cv, (size_t)t * 1536 + c, siluf(y));
    }
}
DEVFN void n5b_norm_gate(const Prm& p, bool do_gate, long gtid, long gn) {
    const proj_t* proj = (const proj_t*)(p.ws + WS_PROJ);
    conv_t* cv = (conv_t*)(p.ws + WS_CONV);
    float* gb = (float*)(p.ws + WS_GB);
    for (long i = gtid; i < (long)T * 32; i += gn) {
        const int t = (int)(i / 32), hh = (int)(i % 32);
        if (hh < 16) {
            float ss = 0.f;
            for (int d = 0; d < 64; ++d) { const float v = ldf(cv, (size_t)t * 1536 + hh * 64 + d); ss += v * v; }
            const float r = 1.f / sqrtf(ss + EPS);
            for (int d = 0; d < 64; ++d) { const float v = ldf(cv, (size_t)t * 1536 + hh * 64 + d); stf(cv, (size_t)t * 1536 + hh * 64 + d, v * r); }
        } else if (do_gate) {
            const int j = hh - 16;
            gb[(size_t)t * 32 + 16 + j] = sigmf(ldf(proj, (size_t)t * IN_W + C_BETA + j));
            gb[(size_t)t * 32 + j] = -expf(p.a_log[j]) * softplusf(ldf(proj, (size_t)t * IN_W + C_ALPHA + j) + p.dt_bias[j]);
        }
    }
}
DEVFN void n6_scan(const Prm& p, long gtid, long gn) {
    const conv_t* cv = (const conv_t*)(p.ws + WS_CONV);
    const float* gb = (const float*)(p.ws + WS_GB);
    float* odir0 = (float*)(p.ws + WS_H); float* odir1 = (float*)(p.ws + WS_OD1);
    for (long i = gtid; i < (long)NSEQ * 8 * 2 * 64; i += gn) {
        const int e = (int)(i % 64), dir = (int)((i / 64) % 2), h = (int)((i / 128) % 8), s = (int)(i / 1024);
        int start, len; seqinfo(s, start, len);
        float S[64];
        if (s >= BATCH) { const float* s0 = (dir == 0 ? p.state_fwd : p.state_bwd) + ((size_t)(s - BATCH) * 8 + h) * 4096;
#pragma unroll
            for (int d = 0; d < 64; ++d) S[d] = s0[d * 64 + e];
        } else {
#pragma unroll
            for (int d = 0; d < 64; ++d) S[d] = 0.f;
        }
        for (int ii = 0; ii < len; ++ii) {
            const int tok = dir == 0 ? start + ii : start + len - 1 - ii;
            const float a = expf(gb[(size_t)tok * 32 + dir * 8 + h]), beta = gb[(size_t)tok * 32 + 16 + dir * 8 + h];
            const conv_t* qp = cv + (size_t)tok * 1536 + h * 64;
            const conv_t* kp = qp + 512;
            const float ve = ldf(cv, (size_t)tok * 1536 + 1024 + h * 64 + e);
            float kS = 0.f;
#pragma unroll
            for (int dg = 0; dg < 4; ++dg) {
#pragma unroll
                for (int d = dg * 16; d < dg * 16 + 16; ++d) { S[d] *= a; kS += ldf(kp, d) * S[d]; }
#ifndef HOST_EMU
                asm volatile("" ::: "memory");
#endif
            }
            const float dl = beta * (ve - kS);
            float o = 0.f;
#pragma unroll
            for (int dg = 0; dg < 4; ++dg) {
#pragma unroll
                for (int d = dg * 16; d < dg * 16 + 16; ++d) { S[d] += ldf(kp, d) * dl; o += ldf(qp, d) * S[d]; }
#ifndef HOST_EMU
                asm volatile("" ::: "memory");
#endif
            }
            (dir == 0 ? odir0 : odir1)[(size_t)tok * 512 + h * 64 + e] = o * 0.125f;
        }
        if (s < BATCH) { float* so = p.out + (dir == 0 ? O_SF : O_SB) + ((size_t)s * 8 + h) * 4096;
#pragma unroll
            for (int d = 0; d < 64; ++d) so[d * 64 + e] = S[d];
        }
    }
}
DEVFN void n7_dnout(const Prm& p, long gtid, long gn) {
    const proj_t* proj = (const proj_t*)(p.ws + WS_PROJ);
    const float* odir0 = (const float*)(p.ws + WS_H); const float* odir1 = (const float*)(p.ws + WS_OD1);
    o_t* od = (o_t*)(p.ws + WS_OD);
    for (long i = gtid; i < (long)T * 8; i += gn) {
        const int t = (int)(i / 8), h = (int)(i % 8);
        float ss = 0.f;
        for (int e = 0; e < 64; ++e) { const float v = odir0[(size_t)t * 512 + h * 64 + e] + odir1[(size_t)t * 512 + h * 64 + e]; ss += v * v; }
        const float r = 1.f / sqrtf(ss / 64.f + EPS);
        for (int e = 0; e < 64; ++e) { const float v = odir0[(size_t)t * 512 + h * 64 + e] + odir1[(size_t)t * 512 + h * 64 + e];
            stf(od, (size_t)t * 512 + h * 64 + e, v * r * p.dn_norm_g[e] * siluf(ldf(proj, (size_t)t * IN_W + C_DZ + h * 64 + e))); }
    }
}
DEVFN void n8_merge(const Prm& p, long gtid, long gn) {
    const proj_t* proj = (const proj_t*)(p.ws + WS_PROJ);
    const o_t* oa = (const o_t*)(p.ws + WS_OA);
    const o_t* od = (const o_t*)(p.ws + WS_OD);
    o_t* mg = (o_t*)(p.ws + WS_MG);
    constexpr int NC = D / 4;
    for (long i = gtid; i < (long)(T / 4) * NC; i += gn) {
        const int r0 = (int)(i / NC) * 4, c0 = (int)(i % NC) * 4;
        float a1[4][4], a2[4][4];
        gemm4x4(oa, 512, p.w_pa, D, 512, r0, c0, a1);
        gemm4x4(od, 512, p.w_pb, D, 512, r0, c0, a2);
#pragma unroll
        for (int a = 0; a < 4; ++a)
#pragma unroll
            for (int b = 0; b < 4; ++b) { const size_t t = r0 + a; const int j = c0 + b;
                stf(mg, t * D + j, sigmf(ldf(proj, t * IN_W + C_GA + j)) * a1[a][b] + sigmf(ldf(proj, t * IN_W + C_GB + j)) * a2[a][b]); }
    }
}
DEVFN void n9_wo(const Prm& p, long gtid, long gn) {
    const o_t* mg = (const o_t*)(p.ws + WS_MG);
    const float* mod = (const float*)(p.ws + WS_MOD);
    constexpr int NC = D / 4;
    for (long i = gtid; i < (long)(T / 4) * NC; i += gn) {
        const int r0 = (int)(i / NC) * 4, c0 = (int)(i % NC) * 4;
        float acc[4][4];
        gemm4x4(mg, D, p.w_o, D, D, r0, c0, acc);
#pragma unroll
        for (int a = 0; a < 4; ++a)
#pragma unroll
            for (int b = 0; b < 4; ++b) { const int t = r0 + a, j = c0 + b;
                p.out[O_Y + (size_t)t * D + j] = xrow(p, t)[j] + mod[(size_t)modidx(t) * 6 * D + 2 * D + j] * acc[a][b]; }
    }
}
DEVFN void n11_ffn_up(const Prm& p, long gtid, long gn) {
    const h_t* h = (const h_t*)(p.ws + WS_H);
    act_t* act = (act_t*)(p.ws + WS_PROJ);
    constexpr int NC = FF / 4;
    for (long i = gtid; i < (long)(T / 4) * NC; i += gn) {
        const int r0 = (int)(i / NC) * 4, c0 = (int)(i % NC) * 4;
        float a1[4][4], a2[4][4];
        gemm4x4(h, D, p.w_gate, FF, D, r0, c0, a1);
        gemm4x4(h, D, p.w_up, FF, D, r0, c0, a2);
#pragma unroll
        for (int a = 0; a < 4; ++a)
#pragma unroll
            for (int b = 0; b < 4; ++b) stf(act, (size_t)(r0 + a) * FF + c0 + b, siluf(a1[a][b]) * a2[a][b]);
    }
}
DEVFN void n12_ffn_down(const Prm& p, long gtid, long gn) {
    const act_t* act = (const act_t*)(p.ws + WS_PROJ);
    const float* mod = (const float*)(p.ws + WS_MOD);
    constexpr int NC = D / 4;
    for (long i = gtid; i < (long)(T / 4) * NC; i += gn) {
        const int r0 = (int)(i / NC) * 4, c0 = (int)(i % NC) * 4;
        float acc[4][4];
        gemm4x4(act, FF, p.w_down, D, FF, r0, c0, acc);
#pragma unroll
        for (int a = 0; a < 4; ++a)
#pragma unroll
            for (int b = 0; b < 4; ++b) { const int t = r0 + a, j = c0 + b;
                p.out[O_Y + (size_t)t * D + j] += mod[(size_t)modidx(t) * 6 * D + 5 * D + j] * acc[a][b]; }
    }
}

#ifndef HOST_EMU
namespace pg8 {
#define PG8_LAS __attribute__((address_space(3)))
typedef unsigned short bf16_t;
typedef short bf16x8 __attribute__((ext_vector_type(8)));
typedef float f32x4 __attribute__((ext_vector_type(4)));
typedef unsigned u32x4 __attribute__((ext_vector_type(4)));
constexpr int BM = 256, BK = 64, HALF = 128, HTB = HALF * BK * 2  , STAGE_BYTES = 8 * HTB, NXCD = 8, WGM = 8;

__host__ __device__ __forceinline__ int lds_byte(int r, int c) { const int st = (r >> 4) * 2 + (c >> 5), rr = r & 15, cc = c & 31, ob = rr * 64 + cc * 2; return st * 1024 + (ob ^ (((ob >> 9) & 1) << 5)); }
__host__ __device__ __forceinline__ void stage_rc(int b, int& R, int& C) { const int st = b / 1024, sb = b % 1024, swz = sb ^ (((sb >> 9) & 1) << 5); R = (st >> 1) * 16 + swz / 64; C = (st & 1) * 32 + (swz % 64) / 2; }
__host__ __device__ __forceinline__ int perm32(int rho) { const int n = rho >> 4, i = rho & 15; return 8 * (i >> 2) + 4 * n + (i & 3); }

struct Unit { int pm, pn, kind; };
struct Gemm { const bf16_t* A; const bf16_t* Bt; int M, N, K; const bf16_t* A2; const bf16_t* Bt2; };

struct StaticOrder {
    int nM, nN, nwg, G, c;
    __host__ __device__ void init(int M, int N, int G_, int c_) { nM = M / BM; nN = N / BM; nwg = nM * nN; G = G_; c = c_; }
    __host__ __device__ bool next(int i, Unit& u) const {
        const long L = (long)i * G + c; if (L >= nwg) return false;
        int wgid = (int)L; { const int q = nwg / NXCD, r = nwg % NXCD, xcd = wgid % NXCD, off = wgid / NXCD; wgid = (xcd < r ? xcd * (q + 1) : r * (q + 1) + (xcd - r) * q) + off; }
        const int nig = WGM * nN, gid = wgid / nig, fm = gid * WGM, gsz = (nM - fm) < WGM ? (nM - fm) : WGM;
        u.pm = fm + ((wgid % nig) % gsz); u.pn = (wgid % nig) / gsz; u.kind = 0; return true;
    }
    __device__ __forceinline__ void a_ready(const Unit&) const {}
    __device__ __forceinline__ void done(const Unit&) const {}
};

typedef float f32x2_ __attribute__((ext_vector_type(2)));
typedef __bf16 bf16x2_ __attribute__((ext_vector_type(2)));
__device__ __forceinline__ unsigned cvt_pk_bf16(float lo, float hi) { const f32x2_ v = {lo, hi}; return __builtin_bit_cast(unsigned, __builtin_convertvector(v, bf16x2_)); }
typedef float f32x2 __attribute__((ext_vector_type(2)));

__device__ __forceinline__ void unpack8(u32x4 w, float (&f)[8]) {
    f[0] = __uint_as_float(w.x << 16); f[1] = __uint_as_float(w.x & 0xffff0000u); f[2] = __uint_as_float(w.y << 16); f[3] = __uint_as_float(w.y & 0xffff0000u);
    f[4] = __uint_as_float(w.z << 16); f[5] = __uint_as_float(w.z & 0xffff0000u); f[6] = __uint_as_float(w.w << 16); f[7] = __uint_as_float(w.w & 0xffff0000u);
}
__device__ __forceinline__ u32x4 pack8(const float (&f)[8]) { u32x4 w; w.x = cvt_pk_bf16(f[0], f[1]); w.y = cvt_pk_bf16(f[2], f[3]); w.z = cvt_pk_bf16(f[4], f[5]); w.w = cvt_pk_bf16(f[6], f[7]); return w; }
__device__ __forceinline__ float sigm_(float x) { return __builtin_amdgcn_rcpf(1.f + __expf(-x)); }
struct EpiStore {
    static constexpr bool PERM = true, AFTER_DRAIN = false, TWO_STAGE = false;
    bf16_t* O; int ldc; int gate_pn0; int silu_pn0, silu_pn1;
    __device__ __forceinline__ void operator()(const f32x4 (&acc)[2][2][4][2], const Unit& u, int wr, int wc, int fr, int fq) const {
        const int row0 = u.pm * BM + wr * 64 + fr, col0 = u.pn * BM + wc * 32 + 8 * fq;
        if (u.pn >= gate_pn0) {
#pragma unroll
            for (int ai = 0; ai < 2; ++ai)
#pragma unroll
                for (int m = 0; m < 4; ++m) { bf16_t* rowp = O + (size_t)(row0 + ai * HALF + m * 16) * ldc + col0;
                    float sv[8], rv[8];
#pragma unroll
                    for (int j = 0; j < 8; ++j) { const float ta = __expf(-fmaxf(acc[ai][0][m][j >> 2][j & 3], -80.f)), tb = __expf(-acc[ai][1][m][j >> 2][j & 3]);
                        sv[j] = __builtin_amdgcn_rcpf(1.f + ta); rv[j] = (1.f + ta) * __builtin_amdgcn_rcpf(1.f + tb); }
                    *(u32x4*)rowp = pack8(sv); *(u32x4*)(rowp + HALF) = pack8(rv);
                    __builtin_amdgcn_sched_barrier(0); }
        } else if (u.pn >= silu_pn0 && u.pn < silu_pn1) {
#pragma unroll
            for (int ai = 0; ai < 2; ++ai)
#pragma unroll
                for (int m = 0; m < 4; ++m) { bf16_t* rowp = O + (size_t)(row0 + ai * HALF + m * 16) * ldc + col0;
#pragma unroll
                    for (int bj = 0; bj < 2; ++bj) { float o[8];
#pragma unroll
                        for (int j = 0; j < 8; ++j) { const float z = acc[ai][bj][m][j >> 2][j & 3]; o[j] = z * sigm_(z); }
                        *(u32x4*)(rowp + bj * HALF) = pack8(o); } }
        } else {
#pragma unroll
            for (int ai = 0; ai < 2; ++ai)
#pragma unroll
                for (int m = 0; m < 4; ++m) { bf16_t* rowp = O + (size_t)(row0 + ai * HALF + m * 16) * ldc + col0;
#pragma unroll
                    for (int bj = 0; bj < 2; ++bj) { const f32x4 v0 = acc[ai][bj][m][0], v1 = acc[ai][bj][m][1];
                        u32x4 w; w.x = cvt_pk_bf16(v0[0], v0[1]); w.y = cvt_pk_bf16(v0[2], v0[3]); w.z = cvt_pk_bf16(v1[0], v1[1]); w.w = cvt_pk_bf16(v1[2], v1[3]);
                        *(u32x4*)(rowp + bj * HALF) = w; } }
        }
    }
};
struct EpiMerge {
    static constexpr bool PERM = true, AFTER_DRAIN = false, TWO_STAGE = true;
    bf16_t* O; int ldo; const bf16_t* GS; int ldg;
    __device__ __forceinline__ void mid(f32x4 (&acc)[2][2][4][2], const Unit& u, int wr, int wc, int fr, int fq) const {
        const int row0 = u.pm * BM + wr * 64 + fr, gc0 = u.pn * 2 * BM + wc * 32 + 8 * fq + HALF;
#pragma unroll
        for (int ai = 0; ai < 2; ++ai) { u32x4 rr[4][2];
#pragma unroll
            for (int m = 0; m < 4; ++m)
#pragma unroll
                for (int bj = 0; bj < 2; ++bj) rr[m][bj] = *(const u32x4*)(GS + (size_t)(row0 + ai * HALF + m * 16) * ldg + gc0 + bj * BM);
#pragma unroll
            for (int m = 0; m < 4; ++m)
#pragma unroll
                for (int bj = 0; bj < 2; ++bj) { float r[8]; unpack8(rr[m][bj], r);
#pragma unroll
                    for (int j = 0; j < 8; ++j) acc[ai][bj][m][j >> 2][j & 3] *= r[j]; } }
    }
    __device__ __forceinline__ void operator()(const f32x4 (&acc)[2][2][4][2], const Unit& u, int wr, int wc, int fr, int fq) const {
        const int row0 = u.pm * BM + wr * 64 + fr, col0 = u.pn * BM + wc * 32 + 8 * fq, gc0 = u.pn * 2 * BM + wc * 32 + 8 * fq;
#pragma unroll
        for (int ai = 0; ai < 2; ++ai) { u32x4 ra[4][2];
#pragma unroll
            for (int m = 0; m < 4; ++m)
#pragma unroll
                for (int bj = 0; bj < 2; ++bj) ra[m][bj] = *(const u32x4*)(GS + (size_t)(row0 + ai * HALF + m * 16) * ldg + gc0 + bj * BM);
#pragma unroll
            for (int m = 0; m < 4; ++m)
#pragma unroll
                for (int bj = 0; bj < 2; ++bj) { float sa[8], o[8]; unpack8(ra[m][bj], sa);
#pragma unroll
                    for (int j = 0; j < 8; ++j) o[j] = acc[ai][bj][m][j >> 2][j & 3] * sa[j];
                    *(u32x4*)(O + (size_t)(row0 + ai * HALF + m * 16) * ldo + col0 + bj * HALF) = pack8(o); } }
    }
};
struct EpiResidA {
    static constexpr bool PERM = true, AFTER_DRAIN = false, TWO_STAGE = false;
    const float* xp; const float* xs; bf16_t* X1; const float* mod; int gate_off;
    __device__ __forceinline__ void operator()(const f32x4 (&acc)[2][2][4][2], const Unit& u, int wr, int wc, int fr, int fq) const {
        const int t0 = u.pm * BM; const int row0 = t0 + wr * 64 + fr, col0 = u.pn * BM + wc * 32 + 8 * fq;
        const float* gate = mod + (size_t)modidx(t0) * 6 * D + gate_off;
        const float* base = t0 < TP ? xp : xs - (size_t)TP * D;
        f32x4 gv[2][2];
#pragma unroll
        for (int bj = 0; bj < 2; ++bj)
#pragma unroll
            for (int n = 0; n < 2; ++n) gv[bj][n] = *(const f32x4*)(gate + col0 + bj * HALF + 4 * n);
#pragma unroll
        for (int am = 0; am < 4; ++am) { const int ai = am >> 1, m0 = (am & 1) * 2; f32x4 bv[2][2][2];
#pragma unroll
            for (int m = 0; m < 2; ++m)
#pragma unroll
                for (int bj = 0; bj < 2; ++bj)
#pragma unroll
                    for (int n = 0; n < 2; ++n) bv[m][bj][n] = *(const f32x4*)(base + (size_t)(row0 + ai * HALF + (m0 + m) * 16) * D + col0 + bj * HALF + 4 * n);
#pragma unroll
            for (int m = 0; m < 2; ++m)
#pragma unroll
                for (int bj = 0; bj < 2; ++bj) { const f32x4 y0 = bv[m][bj][0] + gv[bj][0] * acc[ai][bj][m0 + m][0], y1 = bv[m][bj][1] + gv[bj][1] * acc[ai][bj][m0 + m][1];
                    u32x4 w; w.x = cvt_pk_bf16(y0[0], y0[1]); w.y = cvt_pk_bf16(y0[2], y0[3]); w.z = cvt_pk_bf16(y1[0], y1[1]); w.w = cvt_pk_bf16(y1[2], y1[3]);
                    *(u32x4*)(X1 + (size_t)(row0 + ai * HALF + (m0 + m) * 16) * D + col0 + bj * HALF) = w; } }
    }
};
struct EpiResidB {
    static constexpr bool PERM = true, AFTER_DRAIN = false, TWO_STAGE = false;
    const bf16_t* X1; float* out; const float* mod; int gate_off;
    __device__ __forceinline__ void operator()(const f32x4 (&acc)[2][2][4][2], const Unit& u, int wr, int wc, int fr, int fq) const {
        const int t0 = u.pm * BM; const int row0 = t0 + wr * 64 + fr, col0 = u.pn * BM + wc * 32 + 8 * fq;
        const float* gate = mod + (size_t)modidx(t0) * 6 * D + gate_off;
        f32x4 gv[2][2];
#pragma unroll
        for (int bj = 0; bj < 2; ++bj)
#pragma unroll
            for (int n = 0; n < 2; ++n) gv[bj][n] = *(const f32x4*)(gate + col0 + bj * HALF + 4 * n);
#pragma unroll
        for (int ai = 0; ai < 2; ++ai) { u32x4 bv[4][2];
#pragma unroll
            for (int m = 0; m < 4; ++m)
#pragma unroll
                for (int bj = 0; bj < 2; ++bj) bv[m][bj] = *(const u32x4*)(X1 + (size_t)(row0 + ai * HALF + m * 16) * D + col0 + bj * HALF);
#pragma unroll
            for (int m = 0; m < 4; ++m)
#pragma unroll
                for (int bj = 0; bj < 2; ++bj) { float b[8]; unpack8(bv[m][bj], b);
                    const f32x4 b0 = {b[0], b[1], b[2], b[3]}, b1 = {b[4], b[5], b[6], b[7]};
                    float* op = out + (size_t)(row0 + ai * HALF + m * 16) * D + col0 + bj * HALF;
                    *(f32x4*)op = b0 + gv[bj][0] * acc[ai][bj][m][0]; *(f32x4*)(op + 4) = b1 + gv[bj][1] * acc[ai][bj][m][1]; } }
    }
};
struct EpiSwiglu {
    static constexpr bool PERM = true, AFTER_DRAIN = false, TWO_STAGE = false;
    bf16_t* O;
    __device__ __forceinline__ void operator()(const f32x4 (&acc)[2][2][4][2], const Unit& u, int wr, int wc, int fr, int fq) const {
        const int row0 = u.pm * BM + wr * 64 + fr, col0 = u.pn * HALF + wc * 32 + 8 * fq;
#pragma unroll
        for (int ai = 0; ai < 2; ++ai)
#pragma unroll
            for (int m = 0; m < 4; ++m) { float o[8];
#pragma unroll
                for (int j = 0; j < 8; ++j) { const float g = acc[ai][0][m][j >> 2][j & 3], uu = acc[ai][1][m][j >> 2][j & 3]; o[j] = g * sigm_(g) * uu; }
                *(u32x4*)(O + (size_t)(row0 + ai * HALF + m * 16) * FF + col0) = pack8(o); }
    }
};
template <class Epi, class Sched, bool ALIGN_EPI = false, bool SP2 = false>
__device__ __forceinline__ void gemm_phase(PG8_LAS unsigned char* lds, const Gemm g, const Sched& S, const Epi& E) {
    int tid_ = threadIdx.x; asm volatile("" : "+v"(tid_));
    const int tid = tid_, wid = __builtin_amdgcn_readfirstlane(tid >> 6), lane = tid & 63, wr = wid >> 2, wc = wid & 3, fr = lane & 15, fq = lane >> 4;
    const int K = g.K, nt = K / BK;
    unsigned voffA[2], voffB[2];
#pragma unroll
    for (int i = 0; i < 2; ++i) { int R, C; stage_rc(tid * 16 + i * 8192, R, C); const int Rb = Epi::PERM ? ((R & ~31) + perm32(R & 31)) : R;
        voffA[i] = (unsigned)(R * K + C) * 2u; voffB[i] = (unsigned)(Rb * K + C) * 2u; }
    const size_t kstep = (size_t)(BK * 2);
    const size_t hstep = (size_t)HALF * K * 2;
    const size_t tstep = 2 * hstep;
    const unsigned ldsw = (unsigned)wid * 1024u;
    const int aoff = lds_byte(wr * 64 + fr, fq * 8), boff = lds_byte(wc * 32 + fr, fq * 8);
#define PG8_SA(b, h) (((b) * 2 + (h)) * HTB)
#define PG8_SB(b, h) ((4 + (b) * 2 + (h)) * HTB)
#define PG8_STAGE(bufoff, gbase, voff) do { _Pragma("unroll") for (int _i = 0; _i < 2; ++_i) \
        __builtin_amdgcn_global_load_lds((const unsigned*)((const char*)(gbase) + (voff)[_i]), (PG8_LAS unsigned*)(lds + (bufoff) + ldsw + _i * 8192), 16, 0, 0); } while (0)
#define PG8_LDA(dst, b, h) do { _Pragma("unroll") for (int m = 0; m < 4; ++m) _Pragma("unroll") for (int k = 0; k < 2; ++k) dst[m][k] = *(const PG8_LAS bf16x8*)(lds + PG8_SA(b, h) + aoff + m * 2048 + k * 1024); } while (0)
#define PG8_LDB(dst, b, h) do { _Pragma("unroll") for (int n = 0; n < 2; ++n) _Pragma("unroll") for (int k = 0; k < 2; ++k) dst[n][k] = *(const PG8_LAS bf16x8*)(lds + PG8_SB(b, h) + boff + n * 2048 + k * 1024); } while (0)
#define PG8_MMA(ai, bj, At, Bt) do { __builtin_amdgcn_s_setprio(1); _Pragma("unroll") for (int m = 0; m < 4; ++m) _Pragma("unroll") for (int n = 0; n < 2; ++n) _Pragma("unroll") for (int k = 0; k < 2; ++k) \
        acc[ai][bj][m][n] = __builtin_amdgcn_mfma_f32_16x16x32_bf16(Bt[n][k], At[m][k], acc[ai][bj][m][n], 0, 0, 0); __builtin_amdgcn_s_setprio(0); } while (0)
#define PG8_WAIT_V(n) asm volatile("s_waitcnt vmcnt(" #n ")" ::: "memory")
#define PG8_WAIT_L(n) asm volatile("s_waitcnt lgkmcnt(" #n ")" ::: "memory")
#define PG8_BAR __builtin_amdgcn_s_barrier()
#define PG8_SCHED __builtin_amdgcn_sched_barrier(0)
    Unit cur, nxt; int ui = 0;
    if (!S.next(0, cur)) return;
    f32x4 acc[2][2][4][2];
#pragma unroll
    for (int a = 0; a < 2; ++a)
#pragma unroll
        for (int b = 0; b < 2; ++b)
#pragma unroll
            for (int m = 0; m < 4; ++m)
#pragma unroll
                for (int n = 0; n < 2; ++n) acc[a][b][m][n] = (f32x4){0.f, 0.f, 0.f, 0.f};
    bf16x8 At[4][2], B0[2][2], B1[2][2];
    const char* cA = (const char*)(cur.kind ? g.A2 : g.A) + (size_t)cur.pm * tstep; const char* cB = (const char*)(cur.kind ? g.Bt2 : g.Bt) + (size_t)cur.pn * tstep;
    S.a_ready(cur);
    if constexpr (SP2) {
        PG8_STAGE(PG8_SB(0, 0), cB, voffB); PG8_STAGE(PG8_SB(0, 1), cB + hstep, voffB); PG8_STAGE(PG8_SA(0, 0), cA, voffA); PG8_STAGE(PG8_SA(0, 1), cA + hstep, voffA);
        if (wr == 1) PG8_BAR;
        PG8_WAIT_V(2); PG8_BAR;
        PG8_STAGE(PG8_SB(1, 0), cB + kstep, voffB); PG8_STAGE(PG8_SA(1, 0), cA + kstep, voffA); PG8_STAGE(PG8_SB(1, 1), cB + hstep + kstep, voffB);
        PG8_WAIT_V(6); PG8_BAR;
    } else {
        PG8_STAGE(PG8_SB(0, 0), cB, voffB); PG8_STAGE(PG8_SA(0, 0), cA, voffA); PG8_STAGE(PG8_SB(0, 1), cB + hstep, voffB); PG8_STAGE(PG8_SA(0, 1), cA + hstep, voffA);
        if (wr == 1) PG8_BAR;
        PG8_WAIT_V(4); PG8_BAR;
        PG8_STAGE(PG8_SB(1, 0), cB + kstep, voffB); PG8_STAGE(PG8_SA(1, 0), cA + kstep, voffA); PG8_STAGE(PG8_SB(1, 1), cB + hstep + kstep, voffB);
        PG8_WAIT_V(6); PG8_BAR;
    }
    for (;;) {
        const bool has_next = S.next(ui + 1, nxt);
        const char* nA = has_next ? (const char*)(nxt.kind ? g.A2 : g.A) + (size_t)nxt.pm * tstep : cA; const char* nB = has_next ? (const char*)(nxt.kind ? g.Bt2 : g.Bt) + (size_t)nxt.pn * tstep : cB;
        for (int t = 0; t < nt; t += 2) {
            const bool last = (t == nt - 2);
            const char* a1 = cA + (size_t)(t + 1) * kstep;
            const char* a2 = last ? nA : cA + (size_t)(t + 2) * kstep; const char* b2 = last ? nB : cB + (size_t)(t + 2) * kstep;
            const char* a3 = a2 + kstep; const char* b3 = b2 + kstep;
            if (last && has_next) S.a_ready(nxt);
            if constexpr (SP2) {
            PG8_LDB(B0, 0, 0); PG8_LDB(B1, 0, 1); PG8_SCHED; PG8_LDA(At, 0, 0); PG8_STAGE(PG8_SA(1, 1), a1 + hstep, voffA);
            PG8_WAIT_V(8); PG8_WAIT_L(0); PG8_BAR; PG8_MMA(0, 0, At, B0); PG8_MMA(0, 1, At, B1); PG8_BAR; PG8_SCHED;
            PG8_LDA(At, 0, 1); PG8_STAGE(PG8_SB(0, 0), b2, voffB); PG8_STAGE(PG8_SB(0, 1), b2 + hstep, voffB); PG8_STAGE(PG8_SA(0, 0), a2, voffA);
            PG8_WAIT_V(8); PG8_WAIT_L(0); PG8_BAR; PG8_MMA(1, 0, At, B0); PG8_MMA(1, 1, At, B1); PG8_BAR; PG8_SCHED;
            PG8_LDB(B0, 1, 0); PG8_LDB(B1, 1, 1); PG8_SCHED; PG8_LDA(At, 1, 0); PG8_STAGE(PG8_SA(0, 1), a2 + hstep, voffA);
            PG8_WAIT_V(8); PG8_WAIT_L(0); PG8_BAR; PG8_MMA(0, 0, At, B0); PG8_MMA(0, 1, At, B1); PG8_BAR; PG8_SCHED;
            PG8_LDA(At, 1, 1); PG8_STAGE(PG8_SB(1, 0), b3, voffB); PG8_STAGE(PG8_SB(1, 1), b3 + hstep, voffB); PG8_STAGE(PG8_SA(1, 0), a3, voffA);
            PG8_WAIT_V(8); PG8_WAIT_L(0); PG8_BAR; PG8_MMA(1, 0, At, B0); PG8_MMA(1, 1, At, B1); PG8_BAR; PG8_SCHED;
            } else {
            PG8_LDB(B0, 0, 0); PG8_SCHED; PG8_LDA(At, 0, 0); PG8_STAGE(PG8_SA(1, 1), a1 + hstep, voffA);
            PG8_WAIT_L(8); PG8_BAR; PG8_WAIT_L(0); PG8_MMA(0, 0, At, B0); PG8_BAR; PG8_SCHED;
            PG8_LDB(B1, 0, 1); PG8_STAGE(PG8_SB(0, 0), b2, voffB);
            PG8_BAR; PG8_WAIT_L(0); PG8_MMA(0, 1, At, B1); PG8_BAR;
            PG8_LDA(At, 0, 1); PG8_STAGE(PG8_SA(0, 0), a2, voffA);
            PG8_BAR; PG8_WAIT_L(0); PG8_MMA(1, 0, At, B0); PG8_BAR; PG8_SCHED;
            PG8_STAGE(PG8_SB(0, 1), b2 + hstep, voffB);
            PG8_WAIT_V(6); PG8_BAR; PG8_MMA(1, 1, At, B1); PG8_BAR;
            PG8_LDB(B0, 1, 0); PG8_SCHED; PG8_LDA(At, 1, 0); PG8_STAGE(PG8_SA(0, 1), a2 + hstep, voffA);
            PG8_WAIT_L(8); PG8_BAR; PG8_WAIT_L(0); PG8_MMA(0, 0, At, B0); PG8_BAR; PG8_SCHED;
            PG8_LDB(B1, 1, 1); PG8_STAGE(PG8_SB(1, 0), b3, voffB);
            PG8_BAR; PG8_WAIT_L(0); PG8_MMA(0, 1, At, B1); PG8_BAR;
            PG8_LDA(At, 1, 1); PG8_STAGE(PG8_SA(1, 0), a3, voffA);
            PG8_BAR; PG8_WAIT_L(0); PG8_MMA(1, 0, At, B0); PG8_BAR; PG8_SCHED;
            PG8_STAGE(PG8_SB(1, 1), b3 + hstep, voffB);
            PG8_WAIT_V(6); PG8_BAR; PG8_MMA(1, 1, At, B1); PG8_BAR;
            }
        }
        if constexpr (ALIGN_EPI) { if (wr == 0) PG8_BAR; }
        if constexpr (Epi::TWO_STAGE) { if (cur.kind == 0) E.mid(acc, cur, wr, wc, fr, fq); else E(acc, cur, wr, wc, fr, fq); S.done(cur); }
        else if constexpr (!Epi::AFTER_DRAIN) { E(acc, cur, wr, wc, fr, fq); S.done(cur); }
        if (!has_next) break;
        if (!(Epi::TWO_STAGE && cur.kind == 0)) {
#pragma unroll
        for (int a = 0; a < 2; ++a)
#pragma unroll
            for (int b = 0; b < 2; ++b)
#pragma unroll
                for (int m = 0; m < 4; ++m)
#pragma unroll
                    for (int n = 0; n < 2; ++n) acc[a][b][m][n] = (f32x4){0.f, 0.f, 0.f, 0.f};
        }
        cur = nxt; cA = nA; cB = nB; ++ui;
        if constexpr (ALIGN_EPI) { if (wr == 1) PG8_BAR; }
    }
    PG8_WAIT_V(0);
    if constexpr (!ALIGN_EPI) { if (wr == 0) PG8_BAR; }
    PG8_BAR;
    if constexpr (Epi::AFTER_DRAIN) { E.fused(acc, cur, wr, wc, fr, fq, lds, wid, lane); S.done(cur); }
#undef PG8_SA
#undef PG8_SB
#undef PG8_STAGE
#undef PG8_LDA
#undef PG8_LDB
#undef PG8_MMA
#undef PG8_WAIT_V
#undef PG8_WAIT_L
#undef PG8_BAR
#undef PG8_SCHED
}
}

#define LAS __attribute__((address_space(3)))
typedef unsigned v4u __attribute__((ext_vector_type(4)));
typedef float f32x4 __attribute__((ext_vector_type(4)));
typedef short bf16x8 __attribute__((ext_vector_type(8)));
constexpr int NWAVES = 8, NTHREADS = NWAVES * 64;
constexpr int LDS_CTRL = 147456, LDS_BYTES = LDS_CTRL + 1024;
#define LDS_WAIT() asm volatile("s_waitcnt lgkmcnt(0)" ::: "memory")
__device__ __forceinline__ unsigned pk2(float lo, float hi) { return pg8::cvt_pk_bf16(lo, hi); }
template <int CTRL> __device__ __forceinline__ float dppf(float v) { return __builtin_bit_cast(float, __builtin_amdgcn_update_dpp(0, __builtin_bit_cast(int, v), CTRL, 0xF, 0xF, true)); }
constexpr int DPP_X1 = 0xB1, DPP_X2 = 0x4E, DPP_HM = 0x141, DPP_RM = 0x140;
__device__ __forceinline__ float red8(float v) { v += dppf<DPP_X1>(v); v += dppf<DPP_X2>(v); v += dppf<DPP_HM>(v); return v; }
__device__ __forceinline__ float red16(float v) { v = red8(v); v += dppf<DPP_RM>(v); return v; }
template <int CTRL, int ROWMASK> __device__ __forceinline__ float dpp0(float v) { return __builtin_bit_cast(float, __builtin_amdgcn_update_dpp(0, __builtin_bit_cast(int, v), CTRL, ROWMASK, 0xF, false)); }
__device__ __forceinline__ float wave_scan(float v) {
    v += dpp0<0x111, 0xF>(v); v += dpp0<0x112, 0xF>(v); v += dpp0<0x114, 0xF>(v); v += dpp0<0x118, 0xF>(v);
    v += dpp0<0x142, 0xA>(v); v += dpp0<0x143, 0xC>(v); return v; }
__device__ __forceinline__ float lane63(float v) { return __builtin_bit_cast(float, __builtin_amdgcn_readlane(__builtin_bit_cast(int, v), 63)); }
__device__ __forceinline__ float wave_sum(float v) { v = red16(v); v += __shfl_xor(v, 16); v += __shfl_xor(v, 32); return v; }
struct WItem { const float* src; bf16_t* dst; int ldw, ldt; };
__device__ __forceinline__ bool p0_item(const Prm& p, int it, WItem& w) {
    constexpr int I_IN = (D / 64) * (IN_W / 32), I_PA = (512 / 64) * (D / 32), I_O = (D / 64) * (D / 32), I_G = (D / 64) * (FF / 32), I_DN = (FF / 64) * (D / 32);
    constexpr int NITEMS = I_IN + 2 * I_PA + I_O + 2 * I_G + I_DN;
    if (it >= NITEMS) return false;
    int r = it;
    if (r < I_IN) { const int nb = IN_W / 32, kb = r / nb, n0 = (r % nb) * 32; const int ge = n0 - 2848, gisb = ge >= D, gf = ge - (gisb ? D : 0);
        const int dst = n0 < 2816 ? n0 : (n0 < 2848 ? N_MAIN + (n0 - 2816) : C_GA + (gf / 128) * 256 + (gisb ? 128 : 0) + (gf % 128));
        w.src = p.w_in + (size_t)(kb * 64) * IN_W + n0; w.ldw = IN_W; w.dst = (bf16_t*)(p.ws + WS_WIN) + (size_t)dst * D + kb * 64; w.ldt = D; return true; } r -= I_IN;
    if (r < 2 * I_PA) { const int b = r >= I_PA; if (b) r -= I_PA; const int nb = D / 32, kb = r / nb, n0 = (r % nb) * 32;
        w.src = (b ? p.w_pb : p.w_pa) + (size_t)(kb * 64) * D + n0; w.ldw = D; w.dst = (bf16_t*)(p.ws + (b ? WS_WPB : WS_WPA)) + (size_t)n0 * 512 + kb * 64; w.ldt = 512; return true; } r -= 2 * I_PA;
    if (r < I_O) { const int nb = D / 32, kb = r / nb, n0 = (r % nb) * 32;
        w.src = p.w_o + (size_t)(kb * 64) * D + n0; w.ldw = D; w.dst = (bf16_t*)(p.ws + WS_WO) + (size_t)n0 * D + kb * 64; w.ldt = D; return true; } r -= I_O;
    if (r < 2 * I_G) { const int up = r >= I_G; if (up) r -= I_G; const int nb = FF / 32, kb = r / nb, n0 = (r % nb) * 32;
        w.src = (up ? p.w_up : p.w_gate) + (size_t)(kb * 64) * FF + n0; w.ldw = FF; w.dst = (bf16_t*)(p.ws + WS_WGU) + (size_t)((n0 / 128) * 256 + (up ? 128 : 0) + (n0 % 128)) * D + kb * 64; w.ldt = D; return true; } r -= 2 * I_G;
    { const int nb = D / 32, kb = r / nb, n0 = (r % nb) * 32;
      w.src = p.w_down + (size_t)(kb * 64) * D + n0; w.ldw = D; w.dst = (bf16_t*)(p.ws + WS_WDN) + (size_t)n0 * FF + kb * 64; w.ldt = FF; return true; }
}
__device__ __forceinline__ void p0_weights(const Prm& p, LAS float* scr, int first, int stride, int end, int lane) {
    WItem cur, nxt; float wv[32], wn[32];
    bool have = first < end && p0_item(p, first, cur);
    if (have) {
#pragma unroll
        for (int i = 0; i < 32; ++i) wv[i] = cur.src[(size_t)(2 * i + (lane >> 5)) * cur.ldw + (lane & 31)];
    }
    for (int it = first; have; it += stride) {
        const bool hn = it + stride < end && p0_item(p, it + stride, nxt);
        if (hn) {
#pragma unroll
            for (int i = 0; i < 32; ++i) wn[i] = nxt.src[(size_t)(2 * i + (lane >> 5)) * nxt.ldw + (lane & 31)];
        }
#pragma unroll
        for (int i = 0; i < 32; ++i) scr[(2 * i + (lane >> 5)) * 33 + (lane & 31)] = wv[i];
        LDS_WAIT(); asm volatile("" ::: "memory");
        const int c = lane & 7;
#pragma unroll
        for (int j = 0; j < 4; ++j) { const int n = (lane >> 3) + 8 * j; const LAS float* s = scr + (8 * c) * 33 + n;
            v4u o; o.x = pk2(s[0 * 33], s[1 * 33]); o.y = pk2(s[2 * 33], s[3 * 33]); o.z = pk2(s[4 * 33], s[5 * 33]); o.w = pk2(s[6 * 33], s[7 * 33]);
            *(v4u*)(cur.dst + (size_t)n * cur.ldt + 8 * c) = o; }
        LDS_WAIT(); asm volatile("" ::: "memory");
        have = hn; cur = nxt;
#pragma unroll
        for (int i = 0; i < 32; ++i) wv[i] = wn[i];
    }
}
constexpr int P0_I_EARLY = (D / 64) * (IN_W / 32) + 2 * ((512 / 64) * (D / 32));
constexpr int P0_I_MID = P0_I_EARLY + (D / 64) * (D / 32) + 0 * ((D / 64) * (FF / 32));
constexpr int P0_NITEMS = P0_I_EARLY + (D / 64) * (D / 32) + 2 * ((D / 64) * (FF / 32)) + (FF / 64) * (D / 32);
constexpr int P0_I_LATE = P0_NITEMS - (FF / 64) * (D / 32);
__device__ __forceinline__ void norm_rows(const Prm& p, int which, int gw, int NGW, int lane) {
    const float* mod = (const float*)(p.ws + WS_MOD);
    bf16_t* h = (bf16_t*)(p.ws + WS_H);
    const float* g = which == 0 ? p.norm1_g : p.norm2_g;
    constexpr int NR = 5;
    for (int tb = gw * NR; tb < T; tb += NGW * NR) {
        f32x4 v[NR][4];
#pragma unroll
        for (int a = 0; a < NR; ++a) { const int t = tb + a < T ? tb + a : T - 1;
            if (which == 0) { const float* x = xrow(p, t);
#pragma unroll
                for (int j = 0; j < 4; ++j) v[a][j] = *(const f32x4*)(x + 4 * lane + 256 * j); }
            else { const bf16_t* xb = (const bf16_t*)(p.ws + WS_X1) + (size_t)t * D;
#pragma unroll
                for (int j = 0; j < 4; ++j) { const uint2 w = *(const uint2*)(xb + 4 * lane + 256 * j);
                    v[a][j] = (f32x4){__uint_as_float(w.x << 16), __uint_as_float(w.x & 0xffff0000u), __uint_as_float(w.y << 16), __uint_as_float(w.y & 0xffff0000u)}; } } }
        int mcur = __builtin_amdgcn_readfirstlane(modidx(tb));
        f32x4 A4[4], B4[4];
#define NORM_LOAD_AB(mi_) do { const float* sh_ = mod + (size_t)(mi_) * 6 * D + (which == 0 ? 0 : 3 * D); const float* sc_ = sh_ + D; _Pragma("unroll") for (int j = 0; j < 4; ++j) { const int c = 4 * lane + 256 * j; \
            const f32x4 g4 = *(const f32x4*)(g + c), sc4 = *(const f32x4*)(sc_ + c); B4[j] = *(const f32x4*)(sh_ + c); A4[j] = g4 * (1.f + sc4); } } while (0)
        NORM_LOAD_AB(mcur);
#pragma unroll
        for (int a = 0; a < NR; ++a) { const int t = tb + a; if (t >= T) break;
            const int mi = __builtin_amdgcn_readfirstlane(modidx(t));
            if (mi != mcur) { mcur = mi; NORM_LOAD_AB(mcur); }
            float ss = 0.f;
#pragma unroll
            for (int j = 0; j < 4; ++j) ss += (v[a][j].x * v[a][j].x + v[a][j].y * v[a][j].y) + (v[a][j].z * v[a][j].z + v[a][j].w * v[a][j].w);
            const float rstd = __builtin_amdgcn_rsqf(wave_sum(ss) * (1.f / D) + EPS);
#pragma unroll
            for (int j = 0; j < 4; ++j) { const int c = 4 * lane + 256 * j;
                const f32x4 y = v[a][j] * rstd * A4[j] + B4[j];
                uint2 o; o.x = pk2(y.x, y.y); o.y = pk2(y.z, y.w);
                *(uint2*)(h + (size_t)t * D + c) = o; } }
#undef NORM_LOAD_AB
    }
}
__device__ __forceinline__ void mini_gemm_gates(const Prm& p, LAS unsigned char* lds, int tid) {
    const bf16_t* A = (const bf16_t*)(p.ws + WS_H);
    const bf16_t* Bt = (const bf16_t*)(p.ws + WS_WIN) + (size_t)N_MAIN * D;
    float* gb = (float*)(p.ws + WS_GB);
    const int wave = __builtin_amdgcn_readfirstlane(tid >> 6), lane = tid & 63, fr = lane & 15, fq = lane >> 4;
    LAS float* part = (LAS float*)lds;
    const f32x4 al4 = *(const f32x4*)(p.a_log + 4 * ((tid & 63) >> 4)), db4 = *(const f32x4*)(p.dt_bias + 4 * ((tid & 63) >> 4));
    const int k0 = wave * 128;
    bf16x8 a[2][4], w[2][4];
#define MG_LOAD(u_) do { const int r0_ = (u_) * 32; _Pragma("unroll") for (int kk = 0; kk < 4; ++kk) { _Pragma("unroll") for (int i = 0; i < 2; ++i) { \
        a[i][kk] = *(const bf16x8*)(A + (size_t)(r0_ + 16 * i + fr) * D + k0 + kk * 32 + fq * 8); w[i][kk] = *(const bf16x8*)(Bt + (size_t)(16 * i + fr) * D + k0 + kk * 32 + fq * 8); } } } while (0)
    if ((int)blockIdx.x < T / 32) MG_LOAD((int)blockIdx.x);
    for (int u = blockIdx.x; u < T / 32; u += gridDim.x) {
        const int r0 = u * 32;
        f32x4 acc[2][2];
#pragma unroll
        for (int i = 0; i < 2; ++i)
#pragma unroll
            for (int j = 0; j < 2; ++j) { acc[i][j] = (f32x4){0.f, 0.f, 0.f, 0.f};
#pragma unroll
                for (int kk = 0; kk < 4; ++kk) acc[i][j] = __builtin_amdgcn_mfma_f32_16x16x32_bf16(w[j][kk], a[i][kk], acc[i][j], 0, 0, 0); }
#pragma unroll
        for (int i = 0; i < 2; ++i)
#pragma unroll
            for (int j = 0; j < 2; ++j) *(LAS f32x4*)(part + (((wave * 2 + i) * 2 + j) * 64 + lane) * 4) = acc[i][j];
        if (u + (int)gridDim.x < T / 32) MG_LOAD(u + (int)gridDim.x);
        __syncthreads();
        if (tid < 256) { const int i = tid >> 7, j = (tid >> 6) & 1, l = tid & 63;
            f32x4 sum = {0.f, 0.f, 0.f, 0.f};
#pragma unroll
            for (int wv = 0; wv < 8; ++wv) sum += *(const LAS f32x4*)(part + (((wv * 2 + i) * 2 + j) * 64 + l) * 4);
            const size_t t = (size_t)(r0 + 16 * i + (l & 15));
#pragma unroll
            for (int r = 0; r < 4; ++r) { const int cidx = 4 * (l >> 4) + r;
                if (j == 0) gb[t * 32 + 16 + cidx] = pg8::sigm_(sum[r]);
                else { const float xx = sum[r] + db4[r]; gb[t * 32 + cidx] = -__expf(al4[r]) * (xx > 20.f ? xx : __logf(1.f + __expf(xx))); } } }
        __syncthreads();
    }
#undef MG_LOAD
}
__device__ __forceinline__ float fsilu(float x) { return x * __builtin_amdgcn_rcpf(1.f + __expf(-x)); }
__device__ __forceinline__ void mod_gemv(const Prm& p, LAS unsigned char* lds, int tid) {
    static_assert(NMOD == 3 && D == 1024, "mod_gemv is written for three condition vectors of 1024");
    float* mod = (float*)(p.ws + WS_MOD);
    const int wave = __builtin_amdgcn_readfirstlane(tid >> 6), lane = tid & 63;
    LAS f32x4* part = (LAS f32x4*)lds;
    for (int it = blockIdx.x; it < 24 * 4; it += gridDim.x) {
        const int cb = it >> 2, kq = it & 3, j0 = cb * 256 + 4 * lane, kb = kq * 256 + wave * 32;
        f32x4 wr[32];
#pragma unroll
        for (int kk = 0; kk < 32; ++kk) wr[kk] = *(const f32x4*)(p.w_ada + (size_t)(kb + kk) * 6 * D + j0);
        f32x4 a0 = {0.f, 0.f, 0.f, 0.f}, a1 = a0, a2 = a0;
#pragma unroll
        for (int kk = 0; kk < 32; ++kk) { const int k = kb + kk;
            const float s0 = fsilu(p.c_ctx[k]), s1 = fsilu(p.c[k]), s2 = fsilu(p.c[D + k]);
            a0 += s0 * wr[kk]; a1 += s1 * wr[kk]; a2 += s2 * wr[kk]; }
        part[(wave * 3 + 0) * 64 + lane] = a0; part[(wave * 3 + 1) * 64 + lane] = a1; part[(wave * 3 + 2) * 64 + lane] = a2;
        __syncthreads();
        if (wave < 3) { f32x4 sum = {0.f, 0.f, 0.f, 0.f};
#pragma unroll
            for (int w = 0; w < 8; ++w) sum += part[(w * 3 + wave) * 64 + lane];
            if (kq == 0) sum += *(const f32x4*)(p.b_ada + j0);
#pragma unroll
            for (int e2 = 0; e2 < 4; ++e2) atomicAdd(mod + (size_t)wave * 6 * D + j0 + e2, sum[e2]); }
        __syncthreads();
    }
}
__device__ __forceinline__ void qk_prep(const Prm& p, int gw, int NGW, int lane) {
    const bf16_t* proj = (const bf16_t*)(p.ws + WS_PROJ);
    bf16_t* qn = (bf16_t*)(p.ws + WS_QK); bf16_t* kn = qn + (size_t)T * 512;
    const int tk = lane >> 3, l = lane & 7;
    static_assert(T % 8 == 0 && TP % 8 == 0 && DEC_SEQ % 8 == 0, "qk_prep: groups of 8 tokens inside one sequence");
    float gq[8], gk[8];
    { const f32x4 a0 = *(const f32x4*)(p.q_norm_g + 8 * l), a1 = *(const f32x4*)(p.q_norm_g + 8 * l + 4), b0 = *(const f32x4*)(p.k_norm_g + 8 * l), b1 = *(const f32x4*)(p.k_norm_g + 8 * l + 4);
#pragma unroll
      for (int j = 0; j < 4; ++j) { gq[j] = a0[j] * 0.125f; gq[4 + j] = a1[j] * 0.125f; gk[j] = b0[j]; gk[4 + j] = b1[j]; } }
    for (int tb = NGW - 1 - gw; tb < T / 8; tb += NGW) {
        const int t = tb * 8 + tk;
        v4u raw[12];
#pragma unroll
        for (int hh = 0; hh < 12; ++hh) raw[hh] = *(const v4u*)(proj + (size_t)t * IN_W + C_AQ + hh * 64 + 8 * l);
        const bool lat = tb * 8 >= TP;
        float cs[8], sn[8];
        if (lat) { const int pos = (t - TP) % DEC_SEQ; const float pc = (float)(l < 4 ? pos / GRID_W : pos % GRID_W);
#pragma unroll
            for (int j = 0; j < 8; ++j) { const float ang = pc * exp2f(-(float)(8 * (l & 1) + j) * (13.287712379549449f / 16.f)); cs[j] = __cosf(ang); sn[j] = __sinf(ang); } }
#pragma unroll
        for (int hh = 0; hh < 10; ++hh) { const bool isq = hh < 8;
            float v[8]; pg8::unpack8(raw[hh], v);
            float ss = 0.f;
#pragma unroll
            for (int j = 0; j < 8; ++j) ss += v[j] * v[j];
            ss = red8(ss);
            const float rs = __builtin_amdgcn_rsqf(ss * (1.f / 64.f) + EPS);
#pragma unroll
            for (int j = 0; j < 8; ++j) v[j] = v[j] * rs * (isq ? gq[j] : gk[j]);
            if (!isq && !lat) { float* ok = p.out + O_K + ((size_t)t * 2 + (hh - 8)) * 64 + 8 * l;
                *(f32x4*)ok = (f32x4){v[0], v[1], v[2], v[3]}; *(f32x4*)(ok + 4) = (f32x4){v[4], v[5], v[6], v[7]}; }
            if (lat) {
#pragma unroll
                for (int j = 0; j < 8; ++j) { const float pt = dppf<DPP_X2>(v[j]); v[j] = (l & 2) ? v[j] * cs[j] + pt * sn[j] : v[j] * cs[j] - pt * sn[j]; } }
            const v4u o = pg8::pack8(v);
            if (isq) *(v4u*)(qn + (size_t)t * 512 + hh * 64 + 8 * l) = o; else *(v4u*)(kn + (size_t)t * 128 + (hh - 8) * 64 + 8 * l) = o; }
        if (!lat) {
#pragma unroll
            for (int vh = 0; vh < 2; ++vh) { float v[8]; pg8::unpack8(raw[10 + vh], v); float* ov = p.out + O_V + (size_t)t * 128 + vh * 64 + 8 * l;
                *(f32x4*)ov = (f32x4){v[0], v[1], v[2], v[3]}; *(f32x4*)(ov + 4) = (f32x4){v[4], v[5], v[6], v[7]}; } }
    }
}
__device__ __forceinline__ void conv_prep(const Prm& p, int gw, int NGW, int lane) {
    const bf16_t* proj = (const bf16_t*)(p.ws + WS_PROJ);
    bf16_t* cvb = (bf16_t*)(p.ws + WS_CONV);
    for (int it = gw; it < (T / 16) * 3; it += NGW) {
        const int tb = it / 3, part = it % 3, t0 = tb * 16, ch0 = part * 512 + lane * 8;
        int s, pos0; tokinfo(t0, s, pos0); int start, len; seqinfo(s, start, len);
        float w[5][8];
#pragma unroll
        for (int j = 0; j < 5; ++j) { const f32x4 a = *(const f32x4*)(p.conv_w + j * 1536 + ch0), b = *(const f32x4*)(p.conv_w + j * 1536 + ch0 + 4);
#pragma unroll
            for (int e = 0; e < 4; ++e) { w[j][e] = a[e]; w[j][4 + e] = b[e]; } }
        const bf16_t* base = proj + (size_t)start * IN_W + C_DQ + ch0;
        pg8::u32x4 xr[20];
#pragma unroll
        for (int r = 0; r < 20; ++r) { const int pp = pos0 - 2 + r; xr[r] = (pg8::u32x4){0u, 0u, 0u, 0u}; if (pp >= 0 && pp < len) xr[r] = *(const pg8::u32x4*)(base + (size_t)pp * IN_W); }
        float xw[5][8];
#pragma unroll
        for (int r = 0; r < 4; ++r) pg8::unpack8(xr[r], xw[r]);
#pragma unroll
        for (int i = 0; i < 16; ++i) {
            pg8::unpack8(xr[i + 4], xw[(i + 4) % 5]);
            float y[8]; float ss = 0.f;
#pragma unroll
            for (int e = 0; e < 8; ++e) { float a = 0.f;
#pragma unroll
                for (int j = 0; j < 5; ++j) a += w[j][e] * xw[(i + j) % 5][e];
                y[e] = fsilu(a); ss += y[e] * y[e]; }
            if (part < 2) { ss = red8(ss); const float r = __builtin_amdgcn_rsqf(ss + EPS);
#pragma unroll
                for (int e = 0; e < 8; ++e) y[e] *= r; }
            *(pg8::u32x4*)(cvb + (size_t)(t0 + i) * 1536 + ch0) = pg8::pack8(y);
        }
    }
}
#define XB_TMO      128
#define XB_XCNT(j)  (256  + 64 * (j))
#define XB_XSUB(j)  (1280 + 64 * (j))
#define XB_XGEN(j)  (2304 + 64 * (j))
#define XB_TOP      3328
#define XB_TOPGEN   3392
#define XCD_BAR_WORDS 3456
#define XB_SPIN_CAP (1u << 18)

__device__ __forceinline__ unsigned xb_ld(unsigned* p)              { return __hip_atomic_load(p, __ATOMIC_RELAXED, __HIP_MEMORY_SCOPE_AGENT); }
__device__ __forceinline__ unsigned xb_add(unsigned* p, unsigned v) { return __hip_atomic_fetch_add(p, v, __ATOMIC_RELAXED, __HIP_MEMORY_SCOPE_AGENT); }
__device__ __forceinline__ unsigned xb_xcc_id() { return (unsigned)__builtin_amdgcn_s_getreg((3 << 11) | 20) & 0xFu; }
#define XB_SPIN(cond, bar) do { unsigned _sp = 0; while (cond) { __builtin_amdgcn_s_sleep(1); \
    if ((++_sp & 255u) == 0u) { if (xb_ld(&(bar)[XB_TMO])) break; if (_sp > XB_SPIN_CAP) { atomicAdd(&(bar)[XB_TMO], 1u); break; } } } } while (0)

struct XcdBarrier {
    unsigned* bar; unsigned x;
    volatile LAS unsigned* st;
};

__device__ __forceinline__ XcdBarrier xcd_barrier_post(unsigned* bar, volatile LAS unsigned* st) {
    XcdBarrier b; b.bar = bar; b.x = xb_xcc_id(); b.st = st;
    if (threadIdx.x == 0) (void)xb_add(&bar[XB_XCNT(b.x)], 1u);
    return b;
}
__device__ __forceinline__ void xcd_barrier_complete(unsigned* bar, unsigned x, unsigned& nloc, unsigned& nx) {
    const unsigned G = gridDim.x * gridDim.y * gridDim.z;
    unsigned sum, cnt, mine, sp = 0u;
    for (;;) {
        sum = 0u; cnt = 0u; mine = 0u;
#pragma unroll
        for (unsigned j = 0; j < 16; ++j) { const unsigned c = xb_ld(&bar[XB_XCNT(j)]); sum += c; cnt += (c > 0u) ? 1u : 0u; mine = (j == x) ? c : mine; }
        if (sum == G) break;
        __builtin_amdgcn_s_sleep(1);
        if ((++sp & 255u) == 0u) { if (xb_ld(&bar[XB_TMO])) break; if (sp > XB_SPIN_CAP) { atomicAdd(&bar[XB_TMO], 1u); break; } }
    }
    nloc = mine > 0u ? mine : 1u; nx = cnt > 0u ? cnt : 1u;
}

__device__ __forceinline__ void xcd_barrier(const XcdBarrier& b) {
    asm volatile("s_waitcnt vmcnt(0)" ::: "memory");
    __syncthreads();
    if (threadIdx.x == 0) {
        unsigned* bar = b.bar;
        __builtin_amdgcn_s_waitcnt(0);
        unsigned nloc = b.st[0], nx = b.st[1];
        if (nloc == 0u) { xcd_barrier_complete(bar, b.x, nloc, nx); b.st[0] = nloc; b.st[1] = nx; }
        const unsigned old = xb_add(&bar[XB_XSUB(b.x)], 1u);
        const unsigned gen = old / nloc;
        if (old + 1u == (gen + 1u) * nloc) {
            __builtin_amdgcn_fence(__ATOMIC_RELEASE, "agent");
            asm volatile("s_waitcnt vmcnt(0)" ::: "memory");
            (void)xb_add(&bar[XB_TOP], 1u);
            XB_SPIN(xb_ld(&bar[XB_TOP]) < (gen + 1u) * nx, bar);
            __builtin_amdgcn_fence(__ATOMIC_ACQUIRE, "agent");
            asm volatile("s_waitcnt vmcnt(0)" ::: "memory");
        } else {
            XB_SPIN(xb_ld(&bar[XB_TOP]) < (gen + 1u) * nx, bar);
            __builtin_amdgcn_fence(__ATOMIC_ACQUIRE, "agent");
            asm volatile("s_waitcnt vmcnt(0)" ::: "memory");
        }
    }
    __syncthreads();
}

namespace dn {
typedef short s16x4 __attribute__((ext_vector_type(4)));
typedef short s16x8 __attribute__((ext_vector_type(8)));
constexpr int P = 72;
constexpr int OFF_KH = 0, OFF_KT = 9216, OFF_QH = 18432, OFF_VH = 27648, OFF_LB = 36864, OFF_AB = 46080, OFF_WN = 55296,
              OFF_LD = 64512  , OFF_DV = 68864  , OFF_G = 70912, OFF_B = 71168, OFF_EG = 71424, OFF_EGL = 71680, LDS_END = 71936;
__device__ __forceinline__ unsigned cvtpk(float lo, float hi) { return pg8::cvt_pk_bf16(lo, hi); }
__device__ __forceinline__ s16x4 cvt4(f32x4 v) { uint2 u; u.x = cvtpk(v[0], v[1]); u.y = cvtpk(v[2], v[3]); return __builtin_bit_cast(s16x4, u); }
__device__ __forceinline__ f32x4 mfma16(s16x4 a, s16x4 b, f32x4 c) { return __builtin_amdgcn_mfma_f32_16x16x16bf16_1k(a, b, c, 0, 0, 0); }
__device__ __forceinline__ unsigned scale_pk(unsigned w, float s) { return cvtpk(__uint_as_float(w << 16) * s, __uint_as_float(w & 0xffff0000u) * s); }

}


namespace dw {
using dn::s16x4; using dn::s16x8; using dn::cvt4; using dn::mfma16;
__device__ __forceinline__ f32x4 mfma32(s16x8 a, s16x8 b, f32x4 c) { return __builtin_amdgcn_mfma_f32_16x16x32_bf16(a, b, c, 0, 0, 0); }
__device__ __forceinline__ s16x8 cat(s16x4 lo, s16x4 hi) { return __builtin_shufflevector(lo, hi, 0, 1, 2, 3, 4, 5, 6, 7); }
constexpr int GL_FLOATS = 5 * 64;

constexpr int NCHUNK_ = NCHUNK;
__device__ __forceinline__ int chunk_id(int unit, int n) { return unit < BATCH * 16 ? unit * (SEQ / 64) + n : BATCH * 16 * (SEQ / 64) + (unit - BATCH * 16) * (DEC_SEQ / 64) + n; }

__device__ __forceinline__ void pa_task(const Prm& p, LAS float* gl, int unit_, int n_, int lane) {
    const int unit = __builtin_amdgcn_readfirstlane(unit_), n = __builtin_amdgcn_readfirstlane(n_);
    const int q = lane >> 4, c = lane & 15, s = unit >> 4, h = (unit >> 1) & 7, dir = unit & 1;
    int start, len; seqinfo(s, start, len);
    const bf16_t* cv = (const bf16_t*)(p.ws + WS_CONV) + h * 64;
    const float* gb = (const float*)(p.ws + WS_GB);
    LAS float* Gs = gl; LAS float* Bs = gl + 64; LAS float* BEs = gl + 128;
    const f32x4 Z = {0.f, 0.f, 0.f, 0.f};
    const int ci = chunk_id(unit, n);
    v4u* slw = (v4u*)(p.ws + WS_SLW) + (size_t)ci * 512 + lane; v4u* slu = (v4u*)(p.ws + WS_SLU) + (size_t)ci * 512 + lane;
    unsigned char* sla = p.ws + WS_SLA + (size_t)(ci - CHUNK_LAT0) * SLA_BYTES;
    const int sg = dir == 0 ? 1 : -1, t0 = dir == 0 ? start + n * 64 : start + len - 1 - n * 64;
    const int rc = t0 + sg * c;
#define PA_ROWC(b_) (rc + sg * 16 * (b_))
    s16x8 kf[4][2], qfn0, qfn1;
#pragma unroll
    for (int b = 0; b < 4; ++b) { const bf16_t* rp = cv + (size_t)PA_ROWC(b) * 1536 + 8 * q;
        kf[b][0] = *(const s16x8*)(rp + 512); kf[b][1] = *(const s16x8*)(rp + 544); if (b == 0) { qfn0 = *(const s16x8*)rp; qfn1 = *(const s16x8*)(rp + 32); } }
    { const int tg = t0 + sg * lane; const float g = gb[(size_t)tg * 32 + dir * 8 + h], b = gb[(size_t)tg * 32 + 16 + dir * 8 + h];
      float G = g;
      G = wave_scan(G);
      const float Gl = lane63(G), eg = __expf(G);
      Gs[lane] = G; Bs[lane] = b; BEs[lane] = b * eg;
      ((float*)(sla + 5120))[lane] = eg; ((float*)(sla + 5120))[64 + lane] = __expf(Gl - G); }
    __builtin_amdgcn_sched_barrier(0);
    s16x4 LA[4][4], dA[4];
#pragma unroll
    for (int b = 0; b < 4; ++b) {
        const s16x8 qf0 = qfn0, qf1 = qfn1;
        if (b < 3) { const bf16_t* rp = cv + (size_t)PA_ROWC(b + 1) * 1536 + 8 * q; qfn0 = *(const s16x8*)rp; qfn1 = *(const s16x8*)(rp + 32); }
        const float Gi = Gs[16 * b + c], Bi = Bs[16 * b + c];
#pragma unroll
        for (int cb = 0; cb <= b; ++cb) {
            f32x4 t = mfma32(kf[cb][0], kf[b][0], Z); t = mfma32(kf[cb][1], kf[b][1], t);
            f32x4 u = mfma32(kf[cb][0], qf0, Z); u = mfma32(kf[cb][1], qf1, u);
            const f32x4 Gj = *(const LAS f32x4*)(Gs + 16 * cb + 4 * q), Bj = *(const LAS f32x4*)(Bs + 16 * cb + 4 * q);
            f32x4 la, aa, mc, nc;
#pragma unroll
            for (int r = 0; r < 4; ++r) { const int i = 16 * b + c, j = 16 * cb + 4 * q + r;
                const float ea = __expf(fminf(Gi - Gj[r], 0.f));
                la[r] = (i > j) ? -Bi * t[r] * ea : 0.f; aa[r] = (i >= j) ? 0.125f * u[r] * ea : 0.f;
                if (cb == b) { const float eb = __expf(fminf(Gj[r] - Gi, 0.f)); mc[r] = -la[r]; nc[r] = (j > i) ? Bj[r] * t[r] * eb : 0.f; } }
            LA[b][cb] = cvt4(la);
            *(uint2*)(sla + (b * (b + 1) / 2 + cb) * 512 + lane * 8) = __builtin_bit_cast(uint2, cvt4(aa));
            if (cb == b) {
                const s16x4 m1 = cvt4(mc), n1 = cvt4(nc);
                const s16x4 m2 = cvt4(mfma16(n1, m1, Z)), n2 = cvt4(mfma16(m1, n1, Z));
                const s16x4 m4 = cvt4(mfma16(n2, m2, Z)), n4 = cvt4(mfma16(m2, n2, Z));
                const s16x4 n8 = cvt4(mfma16(m4, n4, Z));
                f32x4 P;
#pragma unroll
                for (int r = 0; r < 4; ++r) P[r] = ((4 * q + r == c) ? 1.f : 0.f) - mc[r];
                P = mfma16(n2, cvt4(P), P); P = mfma16(n4, cvt4(P), P); P = mfma16(n8, cvt4(P), P);
                dA[b] = cvt4(P); }
            __builtin_amdgcn_sched_barrier(0);
        }
    }
    s16x8 vf[4][2];
#pragma unroll
    for (int b = 0; b < 4; ++b) { const bf16_t* rp = cv + (size_t)PA_ROWC(b) * 1536 + 1024 + 8 * q; vf[b][0] = *(const s16x8*)rp; vf[b][1] = *(const s16x8*)(rp + 32); }
    s16x4 IB;
#pragma unroll
    for (int j = 0; j < 4; ++j) IB[j] = (4 * q + j == c) ? (short)0x3F80 : (short)0;
#pragma unroll
    for (int ks = 0; ks < 2; ++ks) {
        s16x4 wlo[4], whi[4];
#pragma unroll
        for (int hf = 0; hf < 2; ++hf) {
            s16x8 selh;
#pragma unroll
            for (int j = 0; j < 8; ++j) selh[j] = (8 * q + j == 16 * hf + c) ? (short)0x3F80 : (short)0;
            s16x4 xb[4];
#pragma unroll
            for (int b = 0; b < 4; ++b) { f32x4 acc = mfma32(kf[b][ks], selh, Z) * *(const LAS f32x4*)(BEs + 16 * b + 4 * q);
#pragma unroll
                for (int cb = 0; cb < b; ++cb) acc = mfma16(LA[b][cb], xb[cb], acc);
                xb[b] = cvt4(mfma16(dA[b], cvt4(acc), Z)); }
#pragma unroll
            for (int b = 0; b < 4; ++b) { const s16x4 w = cvt4(-mfma16(xb[b], IB, Z)); if (hf == 0) wlo[b] = w; else whi[b] = w; }
            s16x4 ub[4];
#pragma unroll
            for (int b = 0; b < 4; ++b) { f32x4 acc = mfma32(vf[b][ks], selh, Z) * *(const LAS f32x4*)(Bs + 16 * b + 4 * q);
#pragma unroll
                for (int cb = 0; cb < b; ++cb) acc = mfma16(LA[b][cb], ub[cb], acc);
                ub[b] = cvt4(mfma16(dA[b], cvt4(acc), Z)); }
            slu[(size_t)((2 * ks + hf) * 2 + 0) * 64] = __builtin_bit_cast(v4u, cat(ub[0], ub[1]));
            slu[(size_t)((2 * ks + hf) * 2 + 1) * 64] = __builtin_bit_cast(v4u, cat(ub[2], ub[3]));
            __builtin_amdgcn_sched_barrier(0);
        }
#pragma unroll
        for (int b = 0; b < 4; ++b) slw[(size_t)(b * 2 + ks) * 64] = __builtin_bit_cast(v4u, cat(wlo[b], whi[b]));
    }
#undef PA_ROWC
}

__device__ __forceinline__ void pb1_task(const Prm& p, int unit_, int g_, int lane) {
    const int unit = __builtin_amdgcn_readfirstlane(unit_), g = __builtin_amdgcn_readfirstlane(g_);
    const int q = lane >> 4, c = lane & 15, s = unit >> 4, h = (unit >> 1) & 7, dir = unit & 1;
    int start, len; seqinfo(s, start, len);
    const int nch = len / 64;
    const bf16_t* cv = (const bf16_t*)(p.ws + WS_CONV) + h * 64;
    const f32x4 Z = {0.f, 0.f, 0.f, 0.f};
    f32x4 S[4] = {Z, Z, Z, Z};
    if (s >= BATCH) { const float* s0 = (dir == 0 ? p.state_fwd : p.state_bwd) + ((size_t)(s - BATCH) * 8 + h) * 4096;
#pragma unroll
        for (int db = 0; db < 4; ++db)
#pragma unroll
            for (int r = 0; r < 4; ++r) S[db][r] = s0[(16 * db + 4 * q + r) * 64 + 16 * g + c]; }
    s16x8 WAn[4][2], kfn[4][2]; v4u un0, un1;
#define PB1_LOAD(n_) do { const int ci_ = chunk_id(unit, (n_)); const v4u* slw_ = (const v4u*)(p.ws + WS_SLW) + (size_t)ci_ * 512 + lane; const v4u* slu_ = (const v4u*)(p.ws + WS_SLU) + (size_t)ci_ * 512 + lane; \
        const float* gat_ = (const float*)(p.ws + WS_SLA + (size_t)(ci_ - CHUNK_LAT0) * SLA_BYTES + 5120); const int t0_ = dir == 0 ? start + (n_) * 64 : start + len - 1 - (n_) * 64; \
        _Pragma("unroll") for (int i_ = 0; i_ < 8; ++i_) WAn[i_ >> 1][i_ & 1] = __builtin_bit_cast(s16x8, slw_[(size_t)i_ * 64]); \
        un0 = slu_[(size_t)(g * 2) * 64]; un1 = slu_[(size_t)(g * 2 + 1) * 64]; \
        _Pragma("unroll") for (int b_ = 0; b_ < 4; ++b_) { const bf16_t* rp_ = cv + (size_t)(t0_ + (dir == 0 ? 1 : -1) * (16 * b_ + c)) * 1536 + 512 + 8 * q; kfn[b_][0] = *(const s16x8*)rp_; kfn[b_][1] = *(const s16x8*)(rp_ + 32); } (void)gat_; } while (0)
    PB1_LOAD(0);
#pragma unroll 1
    for (int n = 0; n < nch; ++n) {
        const int ci = chunk_id(unit, n);
        v4u* slu = (v4u*)(p.ws + WS_SLU) + (size_t)ci * 512 + lane; v4u* slv = (v4u*)(p.ws + WS_SLV) + (size_t)(ci - CHUNK_LAT0) * 512 + lane;
        s16x8 KCp[2][4];
#pragma unroll
        for (int db = 0; db < 4; ++db) { s16x8 sl;
#pragma unroll
            for (int j = 0; j < 8; ++j) sl[j] = (8 * q + j == 16 * (db & 1) + c) ? (short)0x3F80 : (short)0;
#pragma unroll
            for (int m = 0; m < 2; ++m) KCp[m][db] = cat(cvt4(mfma32(kfn[2 * m][db >> 1], sl, Z)), cvt4(mfma32(kfn[2 * m + 1][db >> 1], sl, Z))); }
        s16x8 WAp[4][2]; f32x4 egl[4];
        const float* gat = (const float*)(p.ws + WS_SLA + (size_t)(ci - CHUNK_LAT0) * SLA_BYTES + 5120);
#pragma unroll
        for (int i = 0; i < 4; ++i) { WAp[i][0] = WAn[i][0]; WAp[i][1] = WAn[i][1]; egl[i] = *(const f32x4*)(gat + 64 + 16 * i + 4 * q); }
        const v4u u0 = un0, u1 = un1; const float dl = gat[63];
        __builtin_amdgcn_sched_barrier(0);
        PB1_LOAD(n + 1 < nch ? n + 1 : n);
        __builtin_amdgcn_sched_barrier(0);
        const s16x8 sb0 = cat(cvt4(S[0]), cvt4(S[1])), sb1 = cat(cvt4(S[2]), cvt4(S[3]));
        slu[(size_t)(g * 2) * 64] = __builtin_bit_cast(v4u, sb0); slu[(size_t)(g * 2 + 1) * 64] = __builtin_bit_cast(v4u, sb1);
        s16x4 vn[4], vs[4];
#pragma unroll
        for (int tb = 0; tb < 4; ++tb) { const v4u ur = (tb >> 1) ? u1 : u0; const unsigned w0 = (tb & 1) ? ur.z : ur.x, w1 = (tb & 1) ? ur.w : ur.y;
            f32x4 acc = {__uint_as_float(w0 << 16), __uint_as_float(w0 & 0xffff0000u), __uint_as_float(w1 << 16), __uint_as_float(w1 & 0xffff0000u)};
            acc = mfma32(WAp[tb][0], sb0, acc); acc = mfma32(WAp[tb][1], sb1, acc);
            vn[tb] = cvt4(acc); vs[tb] = cvt4(acc * egl[tb]); }
        slv[(size_t)(g * 2) * 64] = __builtin_bit_cast(v4u, cat(vn[0], vn[1])); slv[(size_t)(g * 2 + 1) * 64] = __builtin_bit_cast(v4u, cat(vn[2], vn[3]));
        const s16x8 vs01 = cat(vs[0], vs[1]), vs23 = cat(vs[2], vs[3]);
#pragma unroll
        for (int db = 0; db < 4; ++db) { f32x4 acc = S[db] * dl; acc = mfma32(KCp[0][db], vs01, acc); acc = mfma32(KCp[1][db], vs23, acc); S[db] = acc; }
    }
#undef PB1_LOAD
    if (s < BATCH) { float* so = p.out + (dir == 0 ? O_SF : O_SB) + ((size_t)s * 8 + h) * 4096;
#pragma unroll
        for (int db = 0; db < 4; ++db)
#pragma unroll
            for (int r = 0; r < 4; ++r) so[(16 * db + 4 * q + r) * 64 + 16 * g + c] = S[db][r]; }
}

__device__ __forceinline__ void pc4_task(const Prm& p, int sh_, int j_, int tb_, int lane) {
    const int sh = __builtin_amdgcn_readfirstlane(sh_), j = __builtin_amdgcn_readfirstlane(j_), tbf = __builtin_amdgcn_readfirstlane(tb_);
    const int q = lane >> 4, c = lane & 15, s = sh >> 3, h = sh & 7;
    int start, len; seqinfo(s, start, len);
    const int nch = len / 64;
    const bf16_t* cv = (const bf16_t*)(p.ws + WS_CONV) + h * 64;
    const f32x4 Z = {0.f, 0.f, 0.f, 0.f};
    f32x4 O[4];
    uint2 zq[4];
    { const bf16_t* projz = (const bf16_t*)(p.ws + WS_PROJ);
#pragma unroll
      for (int g = 0; g < 4; ++g) zq[g] = *(const uint2*)(projz + (size_t)(start + 64 * j + 16 * tbf + c) * IN_W + C_DZ + h * 64 + 16 * g + 4 * q); }
    float gnv[4];
#pragma unroll
    for (int g = 0; g < 4; ++g) gnv[g] = p.dn_norm_g[16 * g + c];
#pragma unroll
    for (int dir = 1; dir >= 0; --dir) {
        const int n = dir == 0 ? j : nch - 1 - j, tb = dir == 0 ? tbf : 3 - tbf, ci = chunk_id(sh * 2 + dir, n);
        const v4u* slw = (const v4u*)(p.ws + WS_SLV) + (size_t)(ci - CHUNK_LAT0) * 512 + lane;
        const v4u* slu = (const v4u*)(p.ws + WS_SLU) + (size_t)ci * 512 + lane;
        const unsigned char* sla = p.ws + WS_SLA + (size_t)(ci - CHUNK_LAT0) * SLA_BYTES;
        const int sg = dir == 0 ? 1 : -1, t0 = dir == 0 ? start + n * 64 : start + len - 1 - n * 64;
        v4u sbr[8], vnr[8]; uint2 aar[4];
#pragma unroll
        for (int i = 0; i < 8; ++i) { sbr[i] = slu[(size_t)i * 64]; vnr[i] = slw[(size_t)i * 64]; }
#pragma unroll
        for (int tc = 0; tc < 4; ++tc) aar[tc] = *(const uint2*)(sla + ((tb * (tb + 1) / 2 + (tc <= tb ? tc : 0)) * 512) + lane * 8);
        const f32x4 eg = *(const f32x4*)((const float*)(sla + 5120) + 16 * tb + 4 * q) * 0.125f;
        const bf16_t* rp = cv + (size_t)(t0 + sg * (16 * tb + c)) * 1536 + 4 * q;
        const s16x8 qa0 = cat(*(const s16x4*)rp, *(const s16x4*)(rp + 16)), qa1 = cat(*(const s16x4*)(rp + 32), *(const s16x4*)(rp + 48));
#pragma unroll
        for (int g = 0; g < 4; ++g) {
            const s16x8 sb0 = __builtin_bit_cast(s16x8, sbr[g * 2]), sb1 = __builtin_bit_cast(s16x8, sbr[g * 2 + 1]);
            const s16x8 v01 = __builtin_bit_cast(s16x8, vnr[g * 2]), v23 = __builtin_bit_cast(s16x8, vnr[g * 2 + 1]);
            const s16x4 vn[4] = {__builtin_shufflevector(v01, v01, 0, 1, 2, 3), __builtin_shufflevector(v01, v01, 4, 5, 6, 7), __builtin_shufflevector(v23, v23, 0, 1, 2, 3), __builtin_shufflevector(v23, v23, 4, 5, 6, 7)};
            f32x4 acc = mfma32(qa0, sb0, Z); acc = mfma32(qa1, sb1, acc);
            acc = acc * eg;
#pragma unroll
            for (int tc = 0; tc < 4; ++tc) if (tc <= tb) acc = mfma16(__builtin_bit_cast(s16x4, aar[tc]), vn[tc], acc);
            if (dir == 1) {
#pragma unroll
                for (int r = 0; r < 4; ++r) O[g][r] = __shfl_xor(acc[3 - r], 48);
            } else O[g] += acc;
        }
    }
    s16x4 IB;
#pragma unroll
    for (int jx = 0; jx < 4; ++jx) IB[jx] = (4 * q + jx == c) ? (short)0x3F80 : (short)0;
    bf16_t* odp = (bf16_t*)(p.ws + WS_OD);
    f32x4 ss = Z;
#pragma unroll
    for (int g = 0; g < 4; ++g) ss += O[g] * O[g];
#pragma unroll
    for (int r = 0; r < 4; ++r) { const float v = red16(ss[r]); ss[r] = __builtin_amdgcn_rsqf(v * (1.f / 64.f) + EPS); }
    const int tok = start + 64 * j + 16 * tbf + c;
#pragma unroll
    for (int g = 0; g < 4; ++g) { const float gn = gnv[g];
        const f32x4 y = mfma16(cvt4(O[g] * ss * gn), IB, Z);
        const uint2 zz = zq[g];
        const float z0 = __uint_as_float(zz.x << 16), z1 = __uint_as_float(zz.x & 0xffff0000u), z2 = __uint_as_float(zz.y << 16), z3 = __uint_as_float(zz.y & 0xffff0000u);
        uint2 o; o.x = dn::cvtpk(y[0] * z0, y[1] * z1); o.y = dn::cvtpk(y[2] * z2, y[3] * z3);
        *(uint2*)(odp + (size_t)tok * 512 + h * 64 + 16 * g + 4 * q) = o; }
}

constexpr int MU_SLOT = 16384, MU_GATE = 8 * MU_SLOT, MU_LDS = MU_GATE + 8 * GL_FLOATS * 4;
static_assert(SEQ == 256, "prompt_unit: 4 chunks per direction");
__device__ __forceinline__ void prompt_unit(const Prm& p, LAS unsigned char* lds, int sh_, int tid) {
    const int sh = __builtin_amdgcn_readfirstlane(sh_), wave = __builtin_amdgcn_readfirstlane(tid >> 6), lane = tid & 63, q = lane >> 4, c = lane & 15;
    const int s = sh >> 3, h = sh & 7, start = s * SEQ;
    const bf16_t* cv = (const bf16_t*)(p.ws + WS_CONV) + h * 64;
    const float* gb = (const float*)(p.ws + WS_GB);
    const f32x4 Z = {0.f, 0.f, 0.f, 0.f};
    s16x4 AAr[10];
    { const int dir = wave >> 2, n = wave & 3;
      LAS float* gl = (LAS float*)(lds + MU_GATE) + wave * GL_FLOATS;
      LAS float* Gs = gl; LAS float* Bs = gl + 64; LAS float* EGs = gl + 128; LAS float* BEs = gl + 192; LAS float* EGLs = gl + 256;
      LAS v4u* slw = (LAS v4u*)(lds + wave * MU_SLOT) + lane; LAS v4u* slu = slw + 512;
      const int sg = dir == 0 ? 1 : -1, t0 = dir == 0 ? start + n * 64 : start + SEQ - 1 - n * 64;
      const int rc = t0 + sg * c;
#define MU_ROWC(b_) (rc + sg * 16 * (b_))
      s16x8 kf[4][2], qf[4][2], vf[4][2];
#pragma unroll
      for (int b = 0; b < 4; ++b) { const bf16_t* rp = cv + (size_t)MU_ROWC(b) * 1536 + 8 * q;
          kf[b][0] = *(const s16x8*)(rp + 512); kf[b][1] = *(const s16x8*)(rp + 544); qf[b][0] = *(const s16x8*)rp; qf[b][1] = *(const s16x8*)(rp + 32); }
      { const int tg = t0 + sg * lane; const float g = gb[(size_t)tg * 32 + dir * 8 + h], b = gb[(size_t)tg * 32 + 16 + dir * 8 + h];
        float G = g;
        G = wave_scan(G);
        const float Gl = lane63(G), eg = __expf(G);
        Gs[lane] = G; Bs[lane] = b; EGs[lane] = eg; BEs[lane] = b * eg; EGLs[lane] = __expf(Gl - G); }
      __builtin_amdgcn_sched_barrier(0);
      s16x4 LA[4][4], dA[4];
#pragma unroll
      for (int b = 0; b < 4; ++b) {
          const s16x8 qf0 = qf[b][0], qf1 = qf[b][1];
          if (b == 3) {
#pragma unroll
              for (int b2 = 0; b2 < 4; ++b2) { const bf16_t* rp = cv + (size_t)MU_ROWC(b2) * 1536 + 1024 + 8 * q; vf[b2][0] = *(const s16x8*)rp; vf[b2][1] = *(const s16x8*)(rp + 32); } }
          const float Gi = Gs[16 * b + c], Bi = Bs[16 * b + c];
#pragma unroll
          for (int cb = 0; cb <= b; ++cb) {
              f32x4 t = mfma32(kf[cb][0], kf[b][0], Z); t = mfma32(kf[cb][1], kf[b][1], t);
              f32x4 u = mfma32(kf[cb][0], qf0, Z); u = mfma32(kf[cb][1], qf1, u);
              const f32x4 Gj = *(const LAS f32x4*)(Gs + 16 * cb + 4 * q), Bj = *(const LAS f32x4*)(Bs + 16 * cb + 4 * q);
              f32x4 la, aa, mc, nc;
#pragma unroll
              for (int r = 0; r < 4; ++r) { const int i = 16 * b + c, j = 16 * cb + 4 * q + r;
                  const float ea = __expf(fminf(Gi - Gj[r], 0.f));
                  la[r] = (i > j) ? -Bi * t[r] * ea : 0.f; aa[r] = (i >= j) ? 0.125f * u[r] * ea : 0.f;
                  if (cb == b) { const float eb = __expf(fminf(Gj[r] - Gi, 0.f)); mc[r] = -la[r]; nc[r] = (j > i) ? Bj[r] * t[r] * eb : 0.f; } }
              LA[b][cb] = cvt4(la); AAr[b * (b + 1) / 2 + cb] = cvt4(aa);
              if (cb == b) {
                  const s16x4 m1 = cvt4(mc), n1 = cvt4(nc);
                  const s16x4 m2 = cvt4(mfma16(n1, m1, Z)), n2 = cvt4(mfma16(m1, n1, Z));
                  const s16x4 m4 = cvt4(mfma16(n2, m2, Z)), n4 = cvt4(mfma16(m2, n2, Z));
                  const s16x4 n8 = cvt4(mfma16(m4, n4, Z));
                  f32x4 P;
#pragma unroll
                  for (int r = 0; r < 4; ++r) P[r] = ((4 * q + r == c) ? 1.f : 0.f) - mc[r];
                  P = mfma16(n2, cvt4(P), P); P = mfma16(n4, cvt4(P), P); P = mfma16(n8, cvt4(P), P);
                  dA[b] = cvt4(P); }
              __builtin_amdgcn_sched_barrier(0);
          }
      }
      s16x4 IB;
#pragma unroll
      for (int j = 0; j < 4; ++j) IB[j] = (4 * q + j == c) ? (short)0x3F80 : (short)0;
#pragma unroll
      for (int ks = 0; ks < 2; ++ks) {
          s16x4 wlo[4], whi[4];
#pragma unroll
          for (int hf = 0; hf < 2; ++hf) {
              s16x8 selh;
#pragma unroll
              for (int j = 0; j < 8; ++j) selh[j] = (8 * q + j == 16 * hf + c) ? (short)0x3F80 : (short)0;
              s16x4 xb[4];
#pragma unroll
              for (int b = 0; b < 4; ++b) { f32x4 acc = mfma32(kf[b][ks], selh, Z) * *(const LAS f32x4*)(BEs + 16 * b + 4 * q);
#pragma unroll
                  for (int cb = 0; cb < b; ++cb) acc = mfma16(LA[b][cb], xb[cb], acc);
                  xb[b] = cvt4(mfma16(dA[b], cvt4(acc), Z)); }
#pragma unroll
              for (int b = 0; b < 4; ++b) { const s16x4 w = cvt4(-mfma16(xb[b], IB, Z)); if (hf == 0) wlo[b] = w; else whi[b] = w; }
              s16x4 ub[4];
#pragma unroll
              for (int b = 0; b < 4; ++b) { f32x4 acc = mfma32(vf[b][ks], selh, Z) * *(const LAS f32x4*)(Bs + 16 * b + 4 * q);
#pragma unroll
                  for (int cb = 0; cb < b; ++cb) acc = mfma16(LA[b][cb], ub[cb], acc);
                  ub[b] = cvt4(mfma16(dA[b], cvt4(acc), Z)); }
              slu[((2 * ks + hf) * 2 + 0) * 64] = __builtin_bit_cast(v4u, cat(ub[0], ub[1]));
              slu[((2 * ks + hf) * 2 + 1) * 64] = __builtin_bit_cast(v4u, cat(ub[2], ub[3]));
              __builtin_amdgcn_sched_barrier(0);
          }
#pragma unroll
          for (int b = 0; b < 4; ++b) slw[(b * 2 + ks) * 64] = __builtin_bit_cast(v4u, cat(wlo[b], whi[b]));
      }
#undef MU_ROWC
    }
    s16x8 qa[4][2];
    __syncthreads();
    { const int dir = wave >> 2, g = wave & 3;
      f32x4 S[4] = {Z, Z, Z, Z};
      s16x8 kfn[4][2];
#define MU_KLOAD(n_) do { const int t0_ = dir == 0 ? start + (n_) * 64 : start + SEQ - 1 - (n_) * 64; _Pragma("unroll") for (int b_ = 0; b_ < 4; ++b_) { \
          const bf16_t* rp_ = cv + (size_t)(t0_ + (dir == 0 ? 1 : -1) * (16 * b_ + c)) * 1536 + 512 + 8 * q; kfn[b_][0] = *(const s16x8*)rp_; kfn[b_][1] = *(const s16x8*)(rp_ + 32); } } while (0)
      MU_KLOAD(0);
#pragma unroll
      for (int n = 0; n < 4; ++n) {
          const int slot = dir * 4 + n;
          if (n == 2) { const int dC = wave >> 2, nC = wave & 3, sgC = dC == 0 ? 1 : -1, t0C = dC == 0 ? start + nC * 64 : start + SEQ - 1 - nC * 64;
#pragma unroll
              for (int tb = 0; tb < 4; ++tb) { const bf16_t* rp = cv + (size_t)(t0C + sgC * (16 * tb + c)) * 1536 + 4 * q;
                  qa[tb][0] = cat(*(const s16x4*)rp, *(const s16x4*)(rp + 16)); qa[tb][1] = cat(*(const s16x4*)(rp + 32), *(const s16x4*)(rp + 48)); } }
          LAS v4u* slw = (LAS v4u*)(lds + slot * MU_SLOT) + lane; LAS v4u* slu = slw + 512;
          LAS float* gl = (LAS float*)(lds + MU_GATE) + slot * GL_FLOATS;
          const int sg = dir == 0 ? 1 : -1, t0 = dir == 0 ? start + n * 64 : start + SEQ - 1 - n * 64;
          s16x8 WAp[4][2], kf[4][2];
#pragma unroll
          for (int b = 0; b < 4; ++b) { kf[b][0] = kfn[b][0]; kf[b][1] = kfn[b][1]; }
          if (n < 3) MU_KLOAD(n + 1);
          (void)sg; (void)t0;
#pragma unroll
          for (int i = 0; i < 8; ++i) WAp[i >> 1][i & 1] = __builtin_bit_cast(s16x8, slw[i * 64]);
          const v4u u0 = slu[(g * 2) * 64], u1 = slu[(g * 2 + 1) * 64];
          const float dl = gl[128 + 63];
          __syncthreads();
          const s16x8 sb0 = cat(cvt4(S[0]), cvt4(S[1])), sb1 = cat(cvt4(S[2]), cvt4(S[3]));
          slu[(g * 2) * 64] = __builtin_bit_cast(v4u, sb0); slu[(g * 2 + 1) * 64] = __builtin_bit_cast(v4u, sb1);
          s16x4 vn[4], vs[4];
#pragma unroll
          for (int tb = 0; tb < 4; ++tb) { const v4u ur = (tb >> 1) ? u1 : u0; const unsigned w0 = (tb & 1) ? ur.z : ur.x, w1 = (tb & 1) ? ur.w : ur.y;
              f32x4 acc = {__uint_as_float(w0 << 16), __uint_as_float(w0 & 0xffff0000u), __uint_as_float(w1 << 16), __uint_as_float(w1 & 0xffff0000u)};
              acc = mfma32(WAp[tb][0], sb0, acc); acc = mfma32(WAp[tb][1], sb1, acc);
              vn[tb] = cvt4(acc); vs[tb] = cvt4(acc * *(const LAS f32x4*)(gl + 256 + 16 * tb + 4 * q)); }
          slw[(g * 2) * 64] = __builtin_bit_cast(v4u, cat(vn[0], vn[1])); slw[(g * 2 + 1) * 64] = __builtin_bit_cast(v4u, cat(vn[2], vn[3]));
          const s16x8 vs01 = cat(vs[0], vs[1]), vs23 = cat(vs[2], vs[3]);
#pragma unroll
          for (int db = 0; db < 4; ++db) { s16x8 sl;
#pragma unroll
              for (int j = 0; j < 8; ++j) sl[j] = (8 * q + j == 16 * (db & 1) + c) ? (short)0x3F80 : (short)0;
              const s16x8 k01 = cat(cvt4(mfma32(kf[0][db >> 1], sl, Z)), cvt4(mfma32(kf[1][db >> 1], sl, Z))), k23 = cat(cvt4(mfma32(kf[2][db >> 1], sl, Z)), cvt4(mfma32(kf[3][db >> 1], sl, Z)));
              f32x4 acc = S[db] * dl; acc = mfma32(k01, vs01, acc); acc = mfma32(k23, vs23, acc); S[db] = acc; }
      }
#undef MU_KLOAD
      float* so = p.out + (dir == 0 ? O_SF : O_SB) + ((size_t)s * 8 + h) * 4096;
#pragma unroll
      for (int db = 0; db < 4; ++db)
#pragma unroll
          for (int r = 0; r < 4; ++r) so[(16 * db + 4 * q + r) * 64 + 16 * g + c] = S[db][r];
    }
    __syncthreads();
    f32x4 O[4][4];
    uint2 zq[4][4];
    { const bf16_t* proj = (const bf16_t*)(p.ws + WS_PROJ);
#pragma unroll
      for (int tb = 0; tb < 4; ++tb)
#pragma unroll
          for (int g = 0; g < 4; ++g) zq[tb][g] = *(const uint2*)(proj + (size_t)(start + 64 * (wave & 3) + 16 * tb + c) * IN_W + C_DZ + h * 64 + 16 * g + 4 * q); }
    float gnv[4];
#pragma unroll
    for (int g = 0; g < 4; ++g) gnv[g] = p.dn_norm_g[16 * g + c];
    { const int dir = wave >> 2, n = wave & 3;
      LAS v4u* slw = (LAS v4u*)(lds + wave * MU_SLOT) + lane; LAS v4u* slu = slw + 512;
      LAS float* gl = (LAS float*)(lds + MU_GATE) + wave * GL_FLOATS;
      const int sg = dir == 0 ? 1 : -1, t0 = dir == 0 ? start + n * 64 : start + SEQ - 1 - n * 64;
      f32x4 eg[4]; (void)sg; (void)t0;
#pragma unroll
      for (int tb = 0; tb < 4; ++tb) eg[tb] = *(const LAS f32x4*)(gl + 128 + 16 * tb + 4 * q) * 0.125f;
#pragma unroll
      for (int g = 0; g < 4; ++g) {
          const s16x8 sb0 = __builtin_bit_cast(s16x8, slu[(g * 2) * 64]), sb1 = __builtin_bit_cast(s16x8, slu[(g * 2 + 1) * 64]);
          const s16x8 v01 = __builtin_bit_cast(s16x8, slw[(g * 2) * 64]), v23 = __builtin_bit_cast(s16x8, slw[(g * 2 + 1) * 64]);
          const s16x4 vn[4] = {__builtin_shufflevector(v01, v01, 0, 1, 2, 3), __builtin_shufflevector(v01, v01, 4, 5, 6, 7), __builtin_shufflevector(v23, v23, 0, 1, 2, 3), __builtin_shufflevector(v23, v23, 4, 5, 6, 7)};
#pragma unroll
          for (int tb = 0; tb < 4; ++tb) { f32x4 acc = mfma32(qa[tb][0], sb0, Z); acc = mfma32(qa[tb][1], sb1, acc);
              acc = acc * eg[tb];
#pragma unroll
              for (int tc = 0; tc <= tb; ++tc) acc = mfma16(AAr[tb * (tb + 1) / 2 + tc], vn[tc], acc);
              O[g][tb] = acc; }
      }
    }
    __syncthreads();
    if (wave >= 4) { LAS f32x4* ob = (LAS f32x4*)(lds + (wave & 3) * MU_SLOT) + lane;
#pragma unroll
        for (int g = 0; g < 4; ++g)
#pragma unroll
            for (int tb = 0; tb < 4; ++tb) ob[(g * 4 + tb) * 64] = O[g][tb]; }
    __syncthreads();
    if (wave < 4) { const int j = wave;
        const LAS float* ob = (const LAS float*)(lds + (3 - j) * MU_SLOT);
#pragma unroll
        for (int g = 0; g < 4; ++g)
#pragma unroll
            for (int tb = 0; tb < 4; ++tb)
#pragma unroll
                for (int r = 0; r < 4; ++r) O[g][tb][r] += ob[((g * 4 + (3 - tb)) * 64 + (lane ^ 48)) * 4 + (3 - r)];
        s16x4 IB;
#pragma unroll
        for (int jx = 0; jx < 4; ++jx) IB[jx] = (4 * q + jx == c) ? (short)0x3F80 : (short)0;
        bf16_t* odp = (bf16_t*)(p.ws + WS_OD);
#pragma unroll
        for (int tb = 0; tb < 4; ++tb) {
            f32x4 ss = Z;
#pragma unroll
            for (int g = 0; g < 4; ++g) ss += O[g][tb] * O[g][tb];
#pragma unroll
            for (int r = 0; r < 4; ++r) { const float v = red16(ss[r]); ss[r] = __builtin_amdgcn_rsqf(v * (1.f / 64.f) + EPS); }
            const int tok = start + 64 * j + 16 * tb + c;
#pragma unroll
            for (int g = 0; g < 4; ++g) { const float gn = gnv[g];
                const f32x4 y = mfma16(cvt4(O[g][tb] * ss * gn), IB, Z);
                const uint2 zz = zq[tb][g];
                const float z0 = __uint_as_float(zz.x << 16), z1 = __uint_as_float(zz.x & 0xffff0000u), z2 = __uint_as_float(zz.y << 16), z3 = __uint_as_float(zz.y & 0xffff0000u);
                uint2 o; o.x = dn::cvtpk(y[0] * z0, y[1] * z1); o.y = dn::cvtpk(y[2] * z2, y[3] * z3);
                *(uint2*)(odp + (size_t)tok * 512 + h * 64 + 16 * g + 4 * q) = o; }
        }
    }
    __syncthreads();
}
}

namespace at {
using dn::s16x4; using dn::s16x8; using dn::cvt4; using dn::mfma16;
constexpr int P = 72, OFF_K = 0, OFF_V = 9216;
__device__ __forceinline__ void attn_unit(const Prm& p, LAS unsigned char* lds, int s, int kvh, int qb, int tid) {
    const int wave = __builtin_amdgcn_readfirstlane(tid >> 6), lane = tid & 63, q4 = lane >> 4, c = lane & 15;
    int start, len; seqinfo(s, start, len);
    const int npast = s >= BATCH ? PAST : 0, ntile = (npast + len) / 64;
    const bf16_t* QB = (const bf16_t*)(p.ws + WS_QK); const bf16_t* KB = QB + (size_t)T * 512;
    const bf16_t* proj = (const bf16_t*)(p.ws + WS_PROJ);
    bf16_t* OA = (bf16_t*)(p.ws + WS_OA);
    constexpr int TILE = 18432;
    const int head = kvh * 4 + (wave >> 1), trow = start + qb * 32 + (wave & 1) * 16 + c;
    s16x8 qf[2];
#pragma unroll
    for (int ks = 0; ks < 2; ++ks) qf[ks] = *(const s16x8*)(QB + (size_t)trow * 512 + head * 64 + 32 * ks + 8 * q4);
    f32x4 o[4];
#pragma unroll
    for (int dt = 0; dt < 4; ++dt) o[dt] = (f32x4){0.f, 0.f, 0.f, 0.f};
    float m = -1e30f, l = 0.f;
    const int lkey = tid >> 3, part = tid & 7;
    v4u kreg, vreg;
#define AT_LOAD(kt) do { const int keyidx = (kt) * 64 + lkey; \
        if (keyidx < npast) { const size_t off = (((size_t)(s - BATCH) * PAST + keyidx) * 2 + kvh) * 64 + part * 8; \
            const f32x4 a = *(const f32x4*)(p.cache_k + off), b = *(const f32x4*)(p.cache_k + off + 4), cc = *(const f32x4*)(p.cache_v + off), d = *(const f32x4*)(p.cache_v + off + 4); \
            kreg.x = dn::cvtpk(a[0], a[1]); kreg.y = dn::cvtpk(a[2], a[3]); kreg.z = dn::cvtpk(b[0], b[1]); kreg.w = dn::cvtpk(b[2], b[3]); \
            vreg.x = dn::cvtpk(cc[0], cc[1]); vreg.y = dn::cvtpk(cc[2], cc[3]); vreg.z = dn::cvtpk(d[0], d[1]); vreg.w = dn::cvtpk(d[2], d[3]); } \
        else { const int tk = start + keyidx - npast; kreg = *(const v4u*)(KB + (size_t)tk * 128 + kvh * 64 + part * 8); vreg = *(const v4u*)(proj + (size_t)tk * IN_W + C_AV + kvh * 64 + part * 8); } } while (0)
#define AT_STORE(buf) do { LAS bf16_t* Kl_ = (LAS bf16_t*)(lds + (buf) * TILE); LAS bf16_t* Vt_ = Kl_ + 64 * P; \
        *(LAS v4u*)(Kl_ + lkey * P + part * 8) = kreg; const unsigned vw_[4] = {vreg.x, vreg.y, vreg.z, vreg.w}; const int ksw_ = lkey ^ (part << 3); \
        _Pragma("unroll") for (int j = 0; j < 4; ++j) { Vt_[(part * 8 + 2 * j) * P + ksw_] = (bf16_t)(vw_[j] & 0xffffu); Vt_[(part * 8 + 2 * j + 1) * P + ksw_] = (bf16_t)(vw_[j] >> 16); } } while (0)
    AT_LOAD(0); AT_STORE(0);
    if (ntile > 1) AT_LOAD(1);
    __syncthreads();
    for (int kt = 0; kt < ntile; ++kt) {
        if (kt + 1 < ntile) { AT_STORE((kt + 1) & 1); if (kt + 2 < ntile) AT_LOAD(kt + 2); }
        const LAS bf16_t* Kl = (const LAS bf16_t*)(lds + (kt & 1) * TILE); const LAS bf16_t* Vt = Kl + 64 * P;
        f32x4 sc[4];
#pragma unroll
        for (int k16 = 0; k16 < 4; ++k16) { f32x4 acc = {0.f, 0.f, 0.f, 0.f};
#pragma unroll
            for (int ks = 0; ks < 2; ++ks) { const s16x8 a = *(const LAS s16x8*)(Kl + (16 * k16 + c) * P + 32 * ks + 8 * q4); acc = __builtin_amdgcn_mfma_f32_16x16x32_bf16(a, qf[ks], acc, 0, 0, 0); }
            sc[k16] = acc; }
        float mx = sc[0][0];
#pragma unroll
        for (int k16 = 0; k16 < 4; ++k16)
#pragma unroll
            for (int r = 0; r < 4; ++r) mx = fmaxf(mx, sc[k16][r]);
        mx = fmaxf(mx, __shfl_xor(mx, 16)); mx = fmaxf(mx, __shfl_xor(mx, 32));
        const float mn = fmaxf(m, mx), alpha = __expf(m - mn); m = mn;
        float rs = 0.f; s16x4 pb[4];
#pragma unroll
        for (int k16 = 0; k16 < 4; ++k16) { f32x4 pv;
#pragma unroll
            for (int r = 0; r < 4; ++r) { pv[r] = __expf(sc[k16][r] - mn); rs += pv[r]; }
            pb[k16] = cvt4(pv); }
        l = l * alpha + rs;
#pragma unroll
        for (int dt = 0; dt < 4; ++dt) { o[dt] *= alpha; const int dsw = ((16 * dt + c) >> 3) << 3;
#pragma unroll
            for (int k16 = 0; k16 < 4; ++k16) { const s16x4 a = *(const LAS s16x4*)(Vt + (16 * dt + c) * P + ((16 * k16 + 4 * q4) ^ dsw)); o[dt] = mfma16(a, pb[k16], o[dt]); } }
        __syncthreads();
    }
#undef AT_LOAD
#undef AT_STORE
    l += __shfl_xor(l, 16); l += __shfl_xor(l, 32);
    const float il = 1.f / l;
#pragma unroll
    for (int dt = 0; dt < 4; ++dt) { uint2 u; u.x = dn::cvtpk(o[dt][0] * il, o[dt][1] * il); u.y = dn::cvtpk(o[dt][2] * il, o[dt][3] * il);
        *(uint2*)(OA + (size_t)trow * 512 + head * 64 + 16 * dt + 4 * q4) = u; }
}

constexpr int PV = SEQ + 8, OFF_VR = SEQ * P * 2;
static_assert(SEQ == 256, "attn_unit_res is written for 256-key prompt sequences");
__device__ __forceinline__ void attn_unit_res(const Prm& p, LAS unsigned char* lds, int s, int kvh, int tid) {
    const int wave = __builtin_amdgcn_readfirstlane(tid >> 6), lane = tid & 63, q4 = lane >> 4, c = lane & 15;
    const int start = s * SEQ;
    const bf16_t* QB = (const bf16_t*)(p.ws + WS_QK); const bf16_t* KB = QB + (size_t)T * 512;
    const bf16_t* proj = (const bf16_t*)(p.ws + WS_PROJ);
    bf16_t* OA = (bf16_t*)(p.ws + WS_OA);
    LAS bf16_t* Kl = (LAS bf16_t*)(lds); LAS bf16_t* Vt = (LAS bf16_t*)(lds + OFF_VR);
    { const int part = tid & 7; v4u kr[4], vr[4];
#pragma unroll
      for (int r = 0; r < 4; ++r) { const int key = (tid >> 3) + 64 * r; const int tk = start + key;
          kr[r] = *(const v4u*)(KB + (size_t)tk * 128 + kvh * 64 + part * 8); vr[r] = *(const v4u*)(proj + (size_t)tk * IN_W + C_AV + kvh * 64 + part * 8); }
#pragma unroll
      for (int r = 0; r < 4; ++r) { const int key = (tid >> 3) + 64 * r;
          *(LAS v4u*)(Kl + key * P + part * 8) = kr[r];
          const unsigned vw[4] = {vr[r].x, vr[r].y, vr[r].z, vr[r].w};
#pragma unroll
          for (int j = 0; j < 4; ++j) { Vt[(part * 8 + 2 * j) * PV + key] = (bf16_t)(vw[j] & 0xffffu); Vt[(part * 8 + 2 * j + 1) * PV + key] = (bf16_t)(vw[j] >> 16); } } }
    s16x8 qn0, qn1;
    { const int head = kvh * 4 + (wave >> 4), trow = start + (wave & 15) * 16 + c;
      qn0 = *(const s16x8*)(QB + (size_t)trow * 512 + head * 64 + 8 * q4); qn1 = *(const s16x8*)(QB + (size_t)trow * 512 + head * 64 + 32 + 8 * q4); }
    __syncthreads();
    for (int task = wave; task < 64; task += 8) {
        const int head = kvh * 4 + (task >> 4), trow = start + (task & 15) * 16 + c;
        const s16x8 qf0 = qn0, qf1 = qn1;
        if (task + 8 < 64) { const int h2 = kvh * 4 + ((task + 8) >> 4), t2 = start + ((task + 8) & 15) * 16 + c;
            qn0 = *(const s16x8*)(QB + (size_t)t2 * 512 + h2 * 64 + 8 * q4); qn1 = *(const s16x8*)(QB + (size_t)t2 * 512 + h2 * 64 + 32 + 8 * q4); }
        f32x4 sc[16];
#pragma unroll
        for (int k16 = 0; k16 < 16; ++k16) { f32x4 acc = {0.f, 0.f, 0.f, 0.f};
            acc = __builtin_amdgcn_mfma_f32_16x16x32_bf16(*(const LAS s16x8*)(Kl + (16 * k16 + c) * P + 8 * q4), qf0, acc, 0, 0, 0);
            acc = __builtin_amdgcn_mfma_f32_16x16x32_bf16(*(const LAS s16x8*)(Kl + (16 * k16 + c) * P + 32 + 8 * q4), qf1, acc, 0, 0, 0);
            sc[k16] = acc;
            if ((k16 & 3) == 3) __builtin_amdgcn_sched_barrier(0); }
        float mx = sc[0][0];
#pragma unroll
        for (int k16 = 0; k16 < 16; ++k16)
#pragma unroll
            for (int r = 0; r < 4; ++r) mx = fmaxf(mx, sc[k16][r]);
        mx = fmaxf(mx, __shfl_xor(mx, 16)); mx = fmaxf(mx, __shfl_xor(mx, 32));
        float rs = 0.f; s16x4 pb[16];
#pragma unroll
        for (int k16 = 0; k16 < 16; ++k16) { f32x4 pv;
#pragma unroll
            for (int r = 0; r < 4; ++r) { pv[r] = __expf(sc[k16][r] - mx); rs += pv[r]; }
            pb[k16] = cvt4(pv); }
        rs += __shfl_xor(rs, 16); rs += __shfl_xor(rs, 32);
        const float il = 1.f / rs;
#pragma unroll
        for (int dt = 0; dt < 4; ++dt) { f32x4 o = {0.f, 0.f, 0.f, 0.f};
#pragma unroll
            for (int k16 = 0; k16 < 16; ++k16) { o = mfma16(*(const LAS s16x4*)(Vt + (16 * dt + c) * PV + 16 * k16 + 4 * q4), pb[k16], o); if ((k16 & 7) == 7) __builtin_amdgcn_sched_barrier(0); }
            uint2 u; u.x = dn::cvtpk(o[0] * il, o[1] * il); u.y = dn::cvtpk(o[2] * il, o[3] * il);
            *(uint2*)(OA + (size_t)trow * 512 + head * 64 + 16 * dt + 4 * q4) = u; }
    }
    __syncthreads();
}
}

__device__ __forceinline__ void attn_queue_latent(const Prm& p, LAS unsigned char* lds, int tid, int ctr_word) {
    constexpr int N_LA = DEC_BATCH * 2 * (DEC_SEQ / 32);
    unsigned* ctr = (unsigned*)(p.ws + WS_BAR) + ctr_word;
    LAS unsigned* slot = (LAS unsigned*)(lds + LDS_CTRL + 16);
    __syncthreads();
    for (;;) {
        if (tid == 0) *slot = atomicAdd(ctr, 1u);
        __syncthreads();
        const int u = __builtin_amdgcn_readfirstlane((int)*slot);
        __syncthreads();
        if (u >= N_LA) break;
        constexpr int per = 2 * (DEC_SEQ / 32); at::attn_unit(p, lds, BATCH + u / per, (u % per) / (DEC_SEQ / 32), u % (DEC_SEQ / 32), tid);
    }
}
__device__ __forceinline__ void attn_queue_prompt(const Prm& p, LAS unsigned char* lds, int tid, int ctr_word) {
    constexpr int N_PA = BATCH * 2;
    unsigned* ctr = (unsigned*)(p.ws + WS_BAR) + ctr_word;
    LAS unsigned* slot = (LAS unsigned*)(lds + LDS_CTRL + 16);
    __syncthreads();
    for (;;) {
        if (tid == 0) *slot = atomicAdd(ctr, 1u);
        __syncthreads();
        const int u = __builtin_amdgcn_readfirstlane((int)*slot);
        __syncthreads();
        if (u >= N_PA) break;
        at::attn_unit_res(p, lds, u >> 1, u & 1, tid);
    }
}
__device__ __forceinline__ void publish_count(unsigned* cnt, int tid) {
    asm volatile("s_waitcnt vmcnt(0)" ::: "memory");
    __syncthreads();
    if (tid == 0) { __builtin_amdgcn_fence(__ATOMIC_RELEASE, "agent"); asm volatile("s_waitcnt vmcnt(0)" ::: "memory"); __hip_atomic_fetch_add(cnt, 1u, __ATOMIC_RELAXED, __HIP_MEMORY_SCOPE_AGENT); }
}
__device__ __forceinline__ void wait_count(unsigned* cnt, unsigned want, int tid) {
    if (tid == 0) { unsigned spins = 0;
        while (__hip_atomic_load(cnt, __ATOMIC_RELAXED, __HIP_MEMORY_SCOPE_AGENT) < want) { __builtin_amdgcn_s_sleep(8); if (++spins > (1u << 22)) break; }
        __builtin_amdgcn_fence(__ATOMIC_ACQUIRE, "agent"); asm volatile("s_waitcnt vmcnt(0)" ::: "memory"); }
    __syncthreads();
}
struct TwoStage {
    pg8::StaticOrder s;
    __device__ bool next(int i, pg8::Unit& u) const { if (!s.next(i >> 1, u)) return false; u.kind = i & 1; return true; }
    __device__ __forceinline__ void a_ready(const pg8::Unit&) const {}
    __device__ __forceinline__ void done(const pg8::Unit&) const {}
};
__device__ __forceinline__ void mix_phase(const Prm& p, LAS unsigned char* lds, int tid, int gw, int wave, int lane) {
    constexpr int N_LSH = DEC_BATCH * 8, N_PAWG = DEC_BATCH * 16 * (DEC_SEQ / 64) / 8;
    static_assert(dw::MU_LDS <= LDS_CTRL, "prompt_unit LDS");
    unsigned* cw = (unsigned*)(p.ws + WS_BAR);
    const int b = blockIdx.x;
    if (b >= (int)gridDim.x / 2) attn_queue_latent(p, lds, tid, 16);
    if (b >= N_LSH && b < N_LSH + N_PAWG) {
        const int t = (b - N_LSH) * 8 + wave;
        dw::pa_task(p, (LAS float*)lds + wave * dw::GL_FLOATS, BATCH * 16 + t / (DEC_SEQ / 64), t % (DEC_SEQ / 64), lane);
        publish_count(cw + 18, tid);
    }
    if (b < N_LSH) {
        wait_count(cw + 18, (unsigned)N_PAWG, tid);
        dw::pb1_task(p, (BATCH * 8 + b) * 2 + (wave >> 2), wave & 3, lane);
        publish_count(cw + 24 + b, tid);
    } else if (b < BATCH * 8) dw::prompt_unit(p, lds, b, tid);
    if (b >= (int)gridDim.x / 2 - N_LSH && b < (int)gridDim.x / 2) dw::prompt_unit(p, lds, b - ((int)gridDim.x / 2 - N_LSH), tid);
    if (!(b >= (int)gridDim.x / 2 - N_LSH && b < (int)gridDim.x / 2)) attn_queue_prompt(p, lds, tid, 20);
    { constexpr int NL4 = DEC_BATCH * 8 * (DEC_SEQ / 64) * 4;
      const int NGW_ = (int)gridDim.x * NWAVES, tk = gw - (NGW_ - NL4);
      if (NGW_ >= NL4 ? tk >= 0 : false) { const int lsh = (tk >> 2) / (DEC_SEQ / 64);
          if (lane == 0) { unsigned spins = 0;
              while (__hip_atomic_load(cw + 24 + lsh, __ATOMIC_RELAXED, __HIP_MEMORY_SCOPE_AGENT) < 1u) { __builtin_amdgcn_s_sleep(8); if (++spins > (1u << 22)) break; } }
          __builtin_amdgcn_fence(__ATOMIC_ACQUIRE, "agent"); asm volatile("s_waitcnt vmcnt(0)" ::: "memory");
          dw::pc4_task(p, BATCH * 8 + lsh, (tk >> 2) % (DEC_SEQ / 64), tk & 3, lane); } }
}
__global__ void __launch_bounds__(NTHREADS, 2) fwd_kernel(Prm p) {
    extern __shared__ __attribute__((aligned(16))) unsigned char lds_raw[];
    LAS unsigned char* lds = (LAS unsigned char*)lds_raw;
    const int tid = threadIdx.x, lane = tid & 63, wave = __builtin_amdgcn_readfirstlane(tid >> 6);
    if (tid < 2) ((LAS unsigned*)(lds + LDS_CTRL))[tid] = 0u;
    __syncthreads();
    const XcdBarrier bar = xcd_barrier_post((unsigned*)(p.ws + WS_BAR), (volatile LAS unsigned*)(lds + LDS_CTRL));
#define GRID_SYNC() xcd_barrier(bar)
    const int G = gridDim.x, gw = blockIdx.x * NWAVES + wave, NGW = G * NWAVES;
    const long gtid = (long)blockIdx.x * NTHREADS + tid, gn = (long)G * NTHREADS;
    unsigned char* ws = p.ws;
    mod_gemv(p, lds, tid); p0_weights(p, (LAS float*)(lds + wave * 16384), gw, NGW, P0_I_EARLY, lane); GRID_SYNC();
    norm_rows(p, 0, gw, NGW, lane); GRID_SYNC();
    { pg8::Gemm g{(const bf16_t*)(ws + WS_H), (const bf16_t*)(ws + WS_WIN), T, N_MAIN, D, nullptr, nullptr}; pg8::StaticOrder S; S.init(T, N_MAIN, G, (int)blockIdx.x);
      pg8::EpiStore E{(bf16_t*)(ws + WS_PROJ), IN_W, C_GA / 256, C_DZ / 256, C_GA / 256};
      pg8::gemm_phase<pg8::EpiStore, pg8::StaticOrder, true, true>(lds, g, S, E); }
    mini_gemm_gates(p, lds, tid);
    GRID_SYNC();
    qk_prep(p, gw, NGW, lane); conv_prep(p, gw, NGW, lane); GRID_SYNC();
    mix_phase(p, lds, tid, gw, wave, lane); GRID_SYNC();
    { constexpr int MERGE_TILES = (T / 256) * (D / 256);
      if ((int)blockIdx.x >= MERGE_TILES) p0_weights(p, (LAS float*)(lds + wave * 16384), P0_I_EARLY + ((int)blockIdx.x - MERGE_TILES) * NWAVES + wave, (G - MERGE_TILES) * NWAVES, P0_I_MID, lane); }
    { pg8::Gemm g{(const bf16_t*)(ws + WS_OD), (const bf16_t*)(ws + WS_WPB), T, D, 512, (const bf16_t*)(ws + WS_OA), (const bf16_t*)(ws + WS_WPA)};
      TwoStage S; S.s.init(T, D, G, (int)blockIdx.x);
      pg8::EpiMerge E{(bf16_t*)(ws + WS_MG), D, (const bf16_t*)(ws + WS_PROJ) + C_GA, IN_W};
      pg8::gemm_phase<pg8::EpiMerge, TwoStage, true, true>(lds, g, S, E); }
    GRID_SYNC();
    { constexpr int WO_TILES = (T / 256) * (D / 256);
      if ((int)blockIdx.x >= WO_TILES) p0_weights(p, (LAS float*)(lds + wave * 16384), P0_I_MID + ((int)blockIdx.x - WO_TILES) * NWAVES + wave, (G - WO_TILES) * NWAVES, P0_I_LATE, lane); }
    { pg8::Gemm g{(const bf16_t*)(ws + WS_MG), (const bf16_t*)(ws + WS_WO), T, D, D, nullptr, nullptr}; pg8::StaticOrder S; S.init(T, D, G, (int)blockIdx.x);
      pg8::EpiResidA E{p.x_prompt, p.x_sample, (bf16_t*)(ws + WS_X1), (const float*)(ws + WS_MOD), 2 * D};
      pg8::gemm_phase<pg8::EpiResidA, pg8::StaticOrder, true, true>(lds, g, S, E); }
    GRID_SYNC();
    norm_rows(p, 1, gw, NGW, lane); GRID_SYNC();
    { pg8::Gemm g{(const bf16_t*)(ws + WS_H), (const bf16_t*)(ws + WS_WGU), T, 2 * FF, D, nullptr, nullptr}; pg8::StaticOrder S; S.init(T, 2 * FF, G, (int)blockIdx.x);
      pg8::EpiSwiglu E{(bf16_t*)(ws + WS_PROJ)};
      pg8::gemm_phase<pg8::EpiSwiglu, pg8::StaticOrder, true, true>(lds, g, S, E);
      constexpr int UP_FULL = (T / 256) * (2 * FF / 256) % 256;
      if ((int)blockIdx.x >= UP_FULL) p0_weights(p, (LAS float*)(lds + wave * 16384), P0_I_LATE + ((int)blockIdx.x - UP_FULL) * NWAVES + wave, (G - UP_FULL) * NWAVES, P0_NITEMS, lane); }
    GRID_SYNC();
    { pg8::Gemm g{(const bf16_t*)(ws + WS_PROJ), (const bf16_t*)(ws + WS_WDN), T, D, FF, nullptr, nullptr}; pg8::StaticOrder S; S.init(T, D, G, (int)blockIdx.x);
      pg8::EpiResidB E{(const bf16_t*)(ws + WS_X1), p.out + O_Y, (const float*)(ws + WS_MOD), 5 * D};
      pg8::gemm_phase<pg8::EpiResidB, pg8::StaticOrder, true, true>(lds, g, S, E); }
}

extern "C" void kernel_launch(void* const* d_in, const int* in_sizes, int n_in, void* d_out, int out_size, void* d_ws, size_t ws_size,
                              hipStream_t stream) {
    static int grid_blocks = 0;
    if (!grid_blocks) {
        int dev = 0, cus = 0, per_cu = 0;
        (void)hipGetDevice(&dev);
        (void)hipDeviceGetAttribute(&cus, hipDeviceAttributeMultiprocessorCount, dev);
        (void)hipFuncSetAttribute((const void*)fwd_kernel, hipFuncAttributeMaxDynamicSharedMemorySize, LDS_BYTES);
        (void)hipOccupancyMaxActiveBlocksPerMultiprocessor(&per_cu, (const void*)fwd_kernel, NTHREADS, LDS_BYTES);
        if (per_cu < 1) { fprintf(stderr, "kernel_launch: occupancy query says %d blocks per CU\n", per_cu); per_cu = 1; }
        grid_blocks = cus;
        if (cus < BATCH * 8) fprintf(stderr, "kernel_launch: this build needs >= %d CUs (one workgroup per prompt (seq, head) unit); device has %d\n", BATCH * 8, cus);
        if (ws_size < WS_END || n_in != 25 || (size_t)out_size != O_END)
            fprintf(stderr, "kernel_launch: unexpected sizes ws %zu (need %zu) n_in %d out %d (expect %zu)\n", ws_size, (size_t)WS_END, n_in, out_size, (size_t)O_END);
    }
    Prm p{};
    const float** pp = (const float**)&p;
    for (int i = 0; i < 25; ++i) pp[i] = (const float*)d_in[i];
    p.out = (float*)d_out; p.ws = (unsigned char*)d_ws;
    (void)hipMemsetAsync((char*)d_ws + WS_BAR, 0, WS_ZERO_BYTES, stream);
    void* args[] = {&p};
    hipError_t e = hipLaunchCooperativeKernel((const void*)fwd_kernel, dim3(grid_blocks), dim3(NTHREADS), args, LDS_BYTES, stream);
    if (e != hipSuccess) fprintf(stderr, "cooperative launch failed: %s (grid %d)\n", hipGetErrorString(e), grid_blocks);
}
#endif
```
